# Optimizing an MI355X kernel written in HIP

```python
import math
import jax, jax.numpy as jnp
from jax import lax
import numpy as np

D_MODEL = 2048
BATCH = 4
SEQ = 2048
DEPTH = 4
DEC_BATCH = 128
DEC_SEQ = 8
PAST_LEN = 16384
PAGE_SIZE = 128

N_MIXERS = 2
N_RET_LAYERS = (DEPTH + 1) // 2
N_CONV_LAYERS = DEPTH // 2
N_META = 16
RET_HEADS = 8
RET_DK = D_MODEL // RET_HEADS
RET_DV = 2 * RET_DK
RET_QK = RET_HEADS * RET_DK
RET_V = RET_HEADS * RET_DV
CHUNK = 128
CONV_WIDTH = 3
CONV_E = D_MODEL
ROPE_BASE = 10000.0
LN_EPS = 1e-5
GN_EPS = 1e-6
DEEPNORM_ALPHA = (2.0 * DEPTH) ** 0.25
DEEPNORM_BETA = (8.0 * DEPTH) ** -0.25

kernel_name = "retnet_shortconv_hybrid_step"


def _decay_log():
    return jnp.log1p(-jnp.exp2(-5.0 - jnp.arange(RET_HEADS, dtype=jnp.float32)))


def layer_norm(x, g, b):
    xf = x.astype(jnp.float32)
    mu = jnp.mean(xf, axis=-1, keepdims=True)
    var = jnp.mean(jnp.square(xf - mu), axis=-1, keepdims=True)
    y = (xf - mu) * lax.rsqrt(var + LN_EPS)
    return (y * g.astype(jnp.float32) + b.astype(jnp.float32)).astype(x.dtype)


def rotary(t, pos):
    half = t.shape[-1] // 2
    freqs = ROPE_BASE ** (-jnp.arange(half, dtype=jnp.float32) * 2.0 / t.shape[-1])
    ang = pos.astype(jnp.float32)[:, None] * freqs[None, :]
    cos = jnp.cos(ang).astype(t.dtype)
    sin = jnp.sin(ang).astype(t.dtype)
    t1, t2 = t[..., :half], t[..., half:]
    return jnp.concatenate([t1 * cos - t2 * sin, t1 * sin + t2 * cos], axis=-1)


def retention_chunk(q, k, v, S):
    dt = q.dtype
    L = q.shape[2]
    lg = _decay_log()
    idx = jnp.arange(L, dtype=jnp.float32)
    diff = idx[:, None] - idx[None, :]
    dmask = jnp.exp(jnp.where(diff[None] >= 0, diff[None] * lg[:, None, None], -jnp.inf)).astype(dt)
    q_decay = jnp.exp((idx + 1.0)[None, :] * lg[:, None]).astype(dt)
    k_decay = jnp.exp((L - 1.0 - idx)[None, :] * lg[:, None]).astype(dt)
    s_decay = jnp.exp(L * lg).astype(dt)
    scores = jnp.einsum('bhld,bhmd->bhlm', q, k) * dmask
    out = (jnp.einsum('bhlm,bhmv->bhlv', scores, v)
           + jnp.einsum('bhld,bhdv->bhlv', q, S) * q_decay[:, :, None])
    S_new = S * s_decay[:, None, None] + jnp.einsum('bhmd,bhmv->bhdv', k * k_decay[:, :, None], v)
    return out, S_new


def retention_prompt(q, k, v):
    B = q.shape[0]
    S0 = jnp.zeros((B, RET_HEADS, RET_DK, RET_DV), q.dtype)
    out_meta, S = retention_chunk(q[:, :, :N_META], k[:, :, :N_META], v[:, :, :N_META], S0)

    def to_chunks(t):
        t = t[:, :, N_META:]
        b, h, l, d = t.shape
        return t.reshape(b, h, l // CHUNK, CHUNK, d).transpose(2, 0, 1, 3, 4)

    def step(S, qkv):
        qc, kc, vc = qkv
        o, S = retention_chunk(qc, kc, vc, S)
        return S, o

    S, outs = lax.scan(step, S, (to_chunks(q), to_chunks(k), to_chunks(v)))
    outs = outs.transpose(1, 2, 0, 3, 4).reshape(B, RET_HEADS, -1, RET_DV)
    return jnp.concatenate([out_meta, outs], axis=2), S


def retention_layer(h, pos, w_in, w_out, state):
    B, L, _ = h.shape
    proj = h @ w_in
    q, k, v, g = jnp.split(proj, [RET_QK, 2 * RET_QK, 2 * RET_QK + RET_V], axis=-1)
    q = q.reshape(B, L, RET_HEADS, RET_DK).transpose(0, 2, 1, 3)
    k = k.reshape(B, L, RET_HEADS, RET_DK).transpose(0, 2, 1, 3)
    v = v.reshape(B, L, RET_HEADS, RET_DV).transpose(0, 2, 1, 3)
    q = rotary(q, pos) * jnp.asarray(RET_DK ** -0.5, q.dtype)
    k = rotary(k, pos)
    if state is None:
        y, S_new = retention_prompt(q, k, v)
    else:
        y, S_new = retention_chunk(q, k, v, state.astype(q.dtype))
    yf = y.astype(jnp.float32)
    mu = jnp.mean(yf, axis=-1, keepdims=True)
    var = jnp.mean(jnp.square(yf - mu), axis=-1, keepdims=True)
    yn = ((yf - mu) * lax.rsqrt(var + GN_EPS)).astype(h.dtype)
    yn = yn.transpose(0, 2, 1, 3).reshape(B, L, RET_V)
    return (jax.nn.silu(g) * yn) @ w_out, S_new


def conv_layer(h, w_in, conv_w, w_out, state):
    L = h.shape[1]
    proj = h @ w_in
    b_gate, c_gate, v, z = jnp.split(proj, 4, axis=-1)
    u = c_gate * v
    if state is None:
        up = jnp.pad(u, ((0, 0), (CONV_WIDTH - 1, 0), (0, 0)))
    else:
        up = jnp.concatenate([state.astype(u.dtype), u], axis=1)
    conv = sum(conv_w[j] * up[:, j:j + L] for j in range(CONV_WIDTH))
    new_state = up[:, -(CONV_WIDTH - 1):]
    return (jax.nn.silu(z) * b_gate * conv) @ w_out, new_state


def setup_inputs(seed: int = 0) -> dict:
    key = jax.random.key(seed)
    ks = jax.random.split(key, 13)
    f32 = jnp.float32
    x_prompt = jax.random.normal(ks[0], (BATCH, SEQ, D_MODEL), f32)
    x_sample = jax.random.normal(ks[1], (DEC_BATCH, DEC_SEQ, D_MODEL), f32)
    gam = 1.0 - np.exp2(-5.0 - np.arange(RET_HEADS, dtype=np.float32))
    s_scale = jnp.asarray((1.0 / (1.0 - gam)) ** 0.5, f32)[None, None, :, None, None]
    state_ret = jax.random.normal(ks[2], (N_RET_LAYERS, DEC_BATCH, RET_HEADS, RET_DK, RET_DV), f32) * s_scale
    state_conv = jax.random.normal(ks[3], (N_CONV_LAYERS, DEC_BATCH, CONV_WIDTH - 1, CONV_E), f32)
    meta = jax.random.normal(ks[4], (N_META, D_MODEL), f32)
    w_ret_in = jax.random.normal(ks[5], (N_RET_LAYERS, D_MODEL, 2 * RET_QK + 2 * RET_V), f32) * D_MODEL ** -0.5
    w_ret_out = (jax.random.normal(ks[6], (N_RET_LAYERS, RET_V, D_MODEL), f32)
                 * (2.0 / (RET_V + D_MODEL)) ** 0.5 * DEEPNORM_BETA)
    w_conv_in = jax.random.normal(ks[7], (N_CONV_LAYERS, D_MODEL, 4 * CONV_E), f32) * D_MODEL ** -0.5
    conv_w = jax.random.normal(ks[8], (N_CONV_LAYERS, CONV_WIDTH, CONV_E), f32) * CONV_WIDTH ** -0.5
    w_conv_out = (jax.random.normal(ks[9], (N_CONV_LAYERS, CONV_E, D_MODEL), f32)
                  * (2.0 / (CONV_E + D_MODEL)) ** 0.5 * DEEPNORM_BETA)
    ln_g = 1.0 + 0.02 * jax.random.normal(ks[10], (DEPTH, D_MODEL), f32)
    ln_b = 0.02 * jax.random.normal(ks[11], (DEPTH, D_MODEL), f32)
    return {"x_prompt": x_prompt, "x_sample": x_sample, "state_ret": state_ret, "state_conv": state_conv,
            "meta": meta, "w_ret_in": w_ret_in, "w_ret_out": w_ret_out, "w_conv_in": w_conv_in,
            "conv_w": conv_w, "w_conv_out": w_conv_out, "ln_g": ln_g, "ln_b": ln_b}


def reference(x_prompt, x_sample, state_ret, state_conv, meta, w_ret_in, w_ret_out,
              w_conv_in, conv_w, w_conv_out, ln_g, ln_b):
    B = x_prompt.shape[0]
    xp = jnp.concatenate(
        [jnp.broadcast_to(meta[None].astype(x_prompt.dtype), (B, N_META, D_MODEL)), x_prompt], axis=1)
    xs = x_sample
    pos_p = jnp.arange(N_META + x_prompt.shape[1], dtype=jnp.int32)
    pos_s = PAST_LEN + jnp.arange(x_sample.shape[1], dtype=jnp.int32)
    alpha = jnp.asarray(DEEPNORM_ALPHA, xp.dtype)
    ret_p, ret_s, conv_p, conv_s = [], [], [], []
    for i in range(DEPTH):
        j = i // N_MIXERS
        if i % N_MIXERS == 0:
            mp, sp = retention_layer(xp, pos_p, w_ret_in[j], w_ret_out[j], None)
            ms, ss = retention_layer(xs, pos_s, w_ret_in[j], w_ret_out[j], state_ret[j])
            ret_p.append(sp)
            ret_s.append(ss)
        else:
            mp, sp = conv_layer(xp, w_conv_in[j], conv_w[j], w_conv_out[j], None)
            ms, ss = conv_layer(xs, w_conv_in[j], conv_w[j], w_conv_out[j], state_conv[j])
            conv_p.append(sp)
            conv_s.append(ss)
        xp = layer_norm(alpha * xp + mp, ln_g[i], ln_b[i])
        xs = layer_norm(alpha * xs + ms, ln_g[i], ln_b[i])
    y_prompt = xp[:, N_META:]
    y_sample = xs
    return (y_prompt, y_sample, jnp.stack(ret_p), jnp.stack(ret_s), jnp.stack(conv_p), jnp.stack(conv_s))
```

```cpp
#include <hip/hip_runtime.h>
#include <cstdio>
#include <cstdint>
#include <cmath>
namespace pg8 {
#define PG8_LAS __attribute__((address_space(3)))
typedef unsigned short bf16_t;
typedef short bf16x8 __attribute__((ext_vector_type(8)));
typedef float f32x4 __attribute__((ext_vector_type(4)));
typedef unsigned u32x4 __attribute__((ext_vector_type(4)));
constexpr int BM = 256, BK = 64, HALF = 128, HTB = HALF * BK * 2  , STAGE_BYTES = 8 * HTB, NXCD = 8, WGM = 8;

__host__ __device__ __forceinline__ int lds_byte(int r, int c) { const int st = (r >> 4) * 2 + (c >> 5), rr = r & 15, cc = c & 31, ob = rr * 64 + cc * 2; return st * 1024 + (ob ^ (((ob >> 9) & 1) << 5)); }
__host__ __device__ __forceinline__ void stage_rc(int b, int& R, int& C) { const int st = b / 1024, sb = b % 1024, swz = sb ^ (((sb >> 9) & 1) << 5); R = (st >> 1) * 16 + swz / 64; C = (st & 1) * 32 + (swz % 64) / 2; }
__host__ __device__ __forceinline__ int perm32(int rho) { const int n = rho >> 4, i = rho & 15; return 8 * (i >> 2) + 4 * n + (i & 3); }

struct Unit { int pm, pn; };
__host__ __device__ __forceinline__ int unit_pn(const Unit& u) { return u.pn & 255; }
__host__ __device__ __forceinline__ int unit_part(const Unit& u) { return (u.pn >> 8) - 1; }
struct Gemm { const bf16_t* A; const bf16_t* Bt; int M, N, K, ld; };

struct StaticOrder {
    int nM, nN, nwg, G, c, ntf;
    __host__ __device__ __forceinline__ void init(int M, int N, int K, int G_, int c_) { nM = M / BM; nN = N / BM; nwg = nM * nN; G = G_; c = c_; ntf = K / BK; }
    __host__ __device__ __forceinline__ bool next(int i, Unit& u) const {
        const long L = (long)i * G + c; if (L >= nwg) return false;
        int wgid = (int)L; { const int q = nwg / NXCD, r = nwg % NXCD, xcd = wgid % NXCD, off = wgid / NXCD; wgid = (xcd < r ? xcd * (q + 1) : r * (q + 1) + (xcd - r) * q) + off; }
        const int nig = WGM * nN, gid = wgid / nig, fm = gid * WGM, gsz = (nM - fm) < WGM ? (nM - fm) : WGM;
        u.pm = fm + ((wgid % nig) % gsz); u.pn = (wgid % nig) / gsz; return true;
    }
    __device__ __forceinline__ void a_ready(const Unit&) const {}
    __device__ __forceinline__ void done(const Unit&) const {}
    __device__ __forceinline__ int nt_of(const Unit&) const { return ntf; }
    __device__ __forceinline__ int k0_of(const Unit&) const { return 0; }
};
struct TailOrder {
    StaticOrder full; int nMf, nMt, nN, G, c, KS, ntp, nfull;
    __host__ __device__ __forceinline__ void init(int Mfull, int M, int N, int K, int KS_, int G_, int c_) { full.init(Mfull, N, K, G_, c_); nMf = Mfull / BM; nMt = M / BM - nMf; nN = N / BM; G = G_; c = c_; KS = KS_; ntp = K / BK / KS_; nfull = nMf * nN; }
    __host__ __device__ __forceinline__ bool next(int i, Unit& u) const {
        const long L = (long)i * G + c;
        if (L < nfull) return full.next(i, u);
        const int j = (int)(L - nfull); if (j >= nMt * nN * KS) return false;
        const int tile = j / KS; u.pm = nMf + tile % nMt; u.pn = tile / nMt + 256 * (1 + j % KS); return true;
    }
    __device__ __forceinline__ void a_ready(const Unit&) const {}
    __device__ __forceinline__ void done(const Unit&) const {}
    __device__ __forceinline__ int nt_of(const Unit& u) const { return (u.pn >> 8) ? ntp : full.ntf; }
    __device__ __forceinline__ int k0_of(const Unit& u) const { const int p = u.pn >> 8; return p ? (p - 1) * ntp * BK : 0; }
};


__device__ __forceinline__ unsigned cvt_pk_bf16(float lo, float hi) { unsigned r; asm volatile("v_cvt_pk_bf16_f32 %0, %1, %2" : "=v"(r) : "v"(lo), "v"(hi)); return r; }
typedef float f32x2 __attribute__((ext_vector_type(2)));
__device__ __forceinline__ f32x2 gelu_pk(f32x2 v) {
    const f32x2 av = __builtin_elementwise_abs(v), d = av * 0.2316418882f + 1.0f;
    f32x2 t; t.x = __builtin_amdgcn_rcpf(d.x); t.y = __builtin_amdgcn_rcpf(d.y);
    f32x2 q = t * 0.5307027145f + (-0.7265760135f); q = q * t + 0.7107068705f; q = q * t + (-0.142248368f); q = q * t + 0.127414796f; q = q * t;
    const f32x2 s = (v * v) * (-0.72134752044f);
    f32x2 e; e.x = __builtin_amdgcn_exp2f(s.x); e.y = __builtin_amdgcn_exp2f(s.y);
    const f32x2 m = v * (q * e), r = v - m;
    f32x2 o; o.x = v.x < 0.f ? m.x : r.x; o.y = v.y < 0.f ? m.y : r.y; return o;
}

template <int ACT  > struct EpiBf16 {
    static constexpr bool PERM = true, AFTER_DRAIN = false; static_assert(ACT == 0 || ACT == 1, "EpiBf16: ACT is 0 (none) or 1 (gelu_pk)");
    bf16_t* O; int ldc; const float* bias; int split_cols; size_t split_stride; float scale0;
    __device__ __forceinline__ void operator()(const f32x4 (&acc)[2][2][4][2], const Unit& u, int wr, int wc, int fr, int fq) const {
        const int row0 = u.pm * BM + wr * 64 + fr; int colt = u.pn * BM; bf16_t* base = O;
        float sc = 1.f; if (split_cols) { const int t = colt / split_cols; base += (size_t)t * split_stride; colt -= t * split_cols; if (t == 0) sc = scale0; }
        const int col0 = colt + wc * 32 + 8 * fq, bcol0 = u.pn * BM + wc * 32 + 8 * fq;
        f32x4 bv[2][2];
#pragma unroll
        for (int bj = 0; bj < 2; ++bj)
#pragma unroll
            for (int n = 0; n < 2; ++n) bv[bj][n] = bias ? *(const f32x4*)(bias + bcol0 + bj * HALF + 4 * n) : (f32x4){0.f, 0.f, 0.f, 0.f};
#pragma unroll
        for (int ai = 0; ai < 2; ++ai)
#pragma unroll
            for (int m = 0; m < 4; ++m) { bf16_t* rowp = base + (size_t)(row0 + ai * HALF + m * 16) * ldc + col0;
#pragma unroll
                for (int bj = 0; bj < 2; ++bj) { f32x4 v0 = acc[ai][bj][m][0] + bv[bj][0], v1 = acc[ai][bj][m][1] + bv[bj][1];
                    if (ACT == 1) { f32x2 a = gelu_pk((f32x2){v0[0], v0[1]}), b = gelu_pk((f32x2){v0[2], v0[3]}), c = gelu_pk((f32x2){v1[0], v1[1]}), d = gelu_pk((f32x2){v1[2], v1[3]});
                        v0 = (f32x4){a.x, a.y, b.x, b.y}; v1 = (f32x4){c.x, c.y, d.x, d.y}; }
                    v0 = v0 * sc; v1 = v1 * sc; u32x4 w; w.x = cvt_pk_bf16(v0[0], v0[1]); w.y = cvt_pk_bf16(v0[2], v0[3]); w.z = cvt_pk_bf16(v1[0], v1[1]); w.w = cvt_pk_bf16(v1[2], v1[3]);
                    *(u32x4*)(rowp + bj * HALF) = w; } }
    }
};

template <class Epi, class Sched, bool ALIGN_EPI = false, bool SP2 = false>
__device__ __forceinline__ void gemm_phase(PG8_LAS unsigned char* lds, const Gemm g, const Sched& S, const Epi& E, const int wave_idx) {
    int tid_ = (int)__builtin_amdgcn_mbcnt_hi(~0u, __builtin_amdgcn_mbcnt_lo(~0u, 0u)); asm volatile("" : "+v"(tid_)); tid_ += 64 * wave_idx;
    const int tid = tid_, wid = __builtin_amdgcn_readfirstlane(tid >> 6), lane = tid & 63, wr = wid >> 2, wc = wid & 3, fr = lane & 15, fq = lane >> 4;
    const int K = g.K;
    unsigned voffA[2], voffB[2];
#pragma unroll
    for (int i = 0; i < 2; ++i) { int R, C; stage_rc(tid * 16 + i * 8192, R, C); const int Rb = Epi::PERM ? ((R & ~31) + perm32(R & 31)) : R;
        voffA[i] = (unsigned)(R * g.ld + C) * 2u; voffB[i] = (unsigned)(Rb * g.ld + C) * 2u; }
    const size_t kstep = (size_t)(BK * 2);
    const size_t hstep = (size_t)HALF * g.ld * 2;
    const size_t tstep = 2 * hstep;
    const unsigned ldsw = (unsigned)wid * 1024u;
    const int aoff = lds_byte(wr * 64 + fr, fq * 8), boff = lds_byte(wc * 32 + fr, fq * 8);
#define PG8_SA(b, h) (((b) * 2 + (h)) * HTB)
#define PG8_SB(b, h) ((4 + (b) * 2 + (h)) * HTB)
#define PG8_STAGE(bufoff, gbase, voff) do { _Pragma("unroll") for (int _i = 0; _i < 2; ++_i) \
        __builtin_amdgcn_global_load_lds((const unsigned*)((const char*)(gbase) + (voff)[_i]), (PG8_LAS unsigned*)(lds + (bufoff) + ldsw + _i * 8192), 16, 0, 0); } while (0)
#define PG8_LDA(dst, b, h) do { _Pragma("unroll") for (int m = 0; m < 4; ++m) _Pragma("unroll") for (int k = 0; k < 2; ++k) dst[m][k] = *(const PG8_LAS bf16x8*)(lds + PG8_SA(b, h) + aoff + m * 2048 + k * 1024); } while (0)
#define PG8_LDB(dst, b, h) do { _Pragma("unroll") for (int n = 0; n < 2; ++n) _Pragma("unroll") for (int k = 0; k < 2; ++k) dst[n][k] = *(const PG8_LAS bf16x8*)(lds + PG8_SB(b, h) + boff + n * 2048 + k * 1024); } while (0)
#define PG8_MMA(ai, bj, At, Bt) do { __builtin_amdgcn_s_setprio(1); _Pragma("unroll") for (int m = 0; m < 4; ++m) _Pragma("unroll") for (int n = 0; n < 2; ++n) _Pragma("unroll") for (int k = 0; k < 2; ++k) \
        acc[ai][bj][m][n] = __builtin_amdgcn_mfma_f32_16x16x32_bf16(Bt[n][k], At[m][k], acc[ai][bj][m][n], 0, 0, 0); __builtin_amdgcn_s_setprio(0); } while (0)
#define PG8_WAIT_V(n) asm volatile("s_waitcnt vmcnt(" #n ")" ::: "memory")
#define PG8_WAIT_L(n) asm volatile("s_waitcnt lgkmcnt(" #n ")" ::: "memory")
#define PG8_BAR __builtin_amdgcn_s_barrier()
#define PG8_SCHED __builtin_amdgcn_sched_barrier(0)
    Unit cur, nxt; int ui = 0;
    if (!S.next(0, cur)) return;
    f32x4 acc[2][2][4][2];
#pragma unroll
    for (int a = 0; a < 2; ++a)
#pragma unroll
        for (int b = 0; b < 2; ++b)
#pragma unroll
            for (int m = 0; m < 4; ++m)
#pragma unroll
                for (int n = 0; n < 2; ++n) acc[a][b][m][n] = (f32x4){0.f, 0.f, 0.f, 0.f};
    bf16x8 At[4][2], B0[2][2], B1[2][2];
    const char* cA = (const char*)g.A + (size_t)cur.pm * tstep + (size_t)S.k0_of(cur) * 2; const char* cB = (const char*)g.Bt + (size_t)unit_pn(cur) * tstep + (size_t)S.k0_of(cur) * 2;
    int nt = S.nt_of(cur);
    S.a_ready(cur);
    if constexpr (SP2) {
        PG8_STAGE(PG8_SB(0, 0), cB, voffB); PG8_STAGE(PG8_SB(0, 1), cB + hstep, voffB); PG8_STAGE(PG8_SA(0, 0), cA, voffA); PG8_STAGE(PG8_SA(0, 1), cA + hstep, voffA);
        if (wr == 1) PG8_BAR;
        PG8_WAIT_V(2); PG8_BAR;
        PG8_STAGE(PG8_SB(1, 0), cB + kstep, voffB); PG8_STAGE(PG8_SA(1, 0), cA + kstep, voffA); PG8_STAGE(PG8_SB(1, 1), cB + hstep + kstep, voffB);
        PG8_WAIT_V(6); PG8_BAR;
    } else {
        PG8_STAGE(PG8_SB(0, 0), cB, voffB); PG8_STAGE(PG8_SA(0, 0), cA, voffA); PG8_STAGE(PG8_SB(0, 1), cB + hstep, voffB); PG8_STAGE(PG8_SA(0, 1), cA + hstep, voffA);
        if (wr == 1) PG8_BAR;
        PG8_WAIT_V(4); PG8_BAR;
        PG8_STAGE(PG8_SB(1, 0), cB + kstep, voffB); PG8_STAGE(PG8_SA(1, 0), cA + kstep, voffA); PG8_STAGE(PG8_SB(1, 1), cB + hstep + kstep, voffB);
        PG8_WAIT_V(6); PG8_BAR;
    }
    for (;;) {
        const bool has_next = S.next(ui + 1, nxt);
        const char* nA = has_next ? (const char*)g.A + (size_t)nxt.pm * tstep + (size_t)S.k0_of(nxt) * 2 : cA; const char* nB = has_next ? (const char*)g.Bt + (size_t)unit_pn(nxt) * tstep + (size_t)S.k0_of(nxt) * 2 : cB;
        for (int t = 0; t < nt; t += 2) {
            const bool last = (t == nt - 2);
            const char* a1 = cA + (size_t)(t + 1) * kstep;
            const char* a2 = last ? nA : cA + (size_t)(t + 2) * kstep; const char* b2 = last ? nB : cB + (size_t)(t + 2) * kstep;
            const char* a3 = a2 + kstep; const char* b3 = b2 + kstep;
            if (last && has_next) S.a_ready(nxt);
            if constexpr (SP2) {
            PG8_LDB(B0, 0, 0); PG8_LDB(B1, 0, 1); PG8_SCHED; PG8_LDA(At, 0, 0); PG8_STAGE(PG8_SA(1, 1), a1 + hstep, voffA);
            PG8_WAIT_V(8); PG8_WAIT_L(0); PG8_BAR; PG8_MMA(0, 0, At, B0); PG8_MMA(0, 1, At, B1); PG8_BAR; PG8_SCHED;
            PG8_LDA(At, 0, 1); PG8_STAGE(PG8_SB(0, 0), b2, voffB); PG8_STAGE(PG8_SB(0, 1), b2 + hstep, voffB); PG8_STAGE(PG8_SA(0, 0), a2, voffA);
            PG8_WAIT_V(8); PG8_WAIT_L(0); PG8_BAR; PG8_MMA(1, 0, At, B0); PG8_MMA(1, 1, At, B1); PG8_BAR; PG8_SCHED;
            PG8_LDB(B0, 1, 0); PG8_LDB(B1, 1, 1); PG8_SCHED; PG8_LDA(At, 1, 0); PG8_STAGE(PG8_SA(0, 1), a2 + hstep, voffA);
            PG8_WAIT_V(8); PG8_WAIT_L(0); PG8_BAR; PG8_MMA(0, 0, At, B0); PG8_MMA(0, 1, At, B1); PG8_BAR; PG8_SCHED;
            PG8_LDA(At, 1, 1); PG8_STAGE(PG8_SB(1, 0), b3, voffB); PG8_STAGE(PG8_SB(1, 1), b3 + hstep, voffB); PG8_STAGE(PG8_SA(1, 0), a3, voffA);
            PG8_WAIT_V(8); PG8_WAIT_L(0); PG8_BAR; PG8_MMA(1, 0, At, B0); PG8_MMA(1, 1, At, B1); PG8_BAR; PG8_SCHED;
            } else {
            PG8_LDB(B0, 0, 0); PG8_SCHED; PG8_LDA(At, 0, 0); PG8_STAGE(PG8_SA(1, 1), a1 + hstep, voffA);
            PG8_WAIT_L(8); PG8_BAR; PG8_WAIT_L(0); PG8_MMA(0, 0, At, B0); PG8_BAR; PG8_SCHED;
            PG8_LDB(B1, 0, 1); PG8_STAGE(PG8_SB(0, 0), b2, voffB);
            PG8_BAR; PG8_WAIT_L(0); PG8_MMA(0, 1, At, B1); PG8_BAR;
            PG8_LDA(At, 0, 1); PG8_STAGE(PG8_SA(0, 0), a2, voffA);
            PG8_BAR; PG8_WAIT_L(0); PG8_MMA(1, 0, At, B0); PG8_BAR; PG8_SCHED;
            PG8_STAGE(PG8_SB(0, 1), b2 + hstep, voffB);
            PG8_WAIT_V(6); PG8_BAR; PG8_MMA(1, 1, At, B1); PG8_BAR;
            PG8_LDB(B0, 1, 0); PG8_SCHED; PG8_LDA(At, 1, 0); PG8_STAGE(PG8_SA(0, 1), a2 + hstep, voffA);
            PG8_WAIT_L(8); PG8_BAR; PG8_WAIT_L(0); PG8_MMA(0, 0, At, B0); PG8_BAR; PG8_SCHED;
            PG8_LDB(B1, 1, 1); PG8_STAGE(PG8_SB(1, 0), b3, voffB);
            PG8_BAR; PG8_WAIT_L(0); PG8_MMA(0, 1, At, B1); PG8_BAR;
            PG8_LDA(At, 1, 1); PG8_STAGE(PG8_SA(1, 0), a3, voffA);
            PG8_BAR; PG8_WAIT_L(0); PG8_MMA(1, 0, At, B0); PG8_BAR; PG8_SCHED;
            PG8_STAGE(PG8_SB(1, 1), b3 + hstep, voffB);
            PG8_WAIT_V(6); PG8_BAR; PG8_MMA(1, 1, At, B1); PG8_BAR;
            }
        }
        if constexpr (ALIGN_EPI) { if (wr == 0) PG8_BAR; }
        if constexpr (!Epi::AFTER_DRAIN) { E(acc, cur, wr, wc, fr, fq); S.done(cur); }
        if (!has_next) break;
#pragma unroll
        for (int a = 0; a < 2; ++a)
#pragma unroll
            for (int b = 0; b < 2; ++b)
#pragma unroll
                for (int m = 0; m < 4; ++m)
#pragma unroll
                    for (int n = 0; n < 2; ++n) acc[a][b][m][n] = (f32x4){0.f, 0.f, 0.f, 0.f};
        cur = nxt; cA = nA; cB = nB; ++ui; nt = S.nt_of(cur);
        if constexpr (ALIGN_EPI) { if (wr == 1) PG8_BAR; }
    }
    PG8_WAIT_V(0);
    if constexpr (!ALIGN_EPI) { if (wr == 0) PG8_BAR; }
    PG8_BAR;
    if constexpr (Epi::AFTER_DRAIN) { E.fused(acc, cur, wr, wc, fr, fq, lds, wid, lane); S.done(cur); }
#undef PG8_SA
#undef PG8_SB
#undef PG8_STAGE
#undef PG8_LDA
#undef PG8_LDB
#undef PG8_MMA
#undef PG8_WAIT_V
#undef PG8_WAIT_L
#undef PG8_BAR
#undef PG8_SCHED
}
}

#ifndef MK_N_LAUNCHES
#define MK_N_LAUNCHES 1
#endif
constexpr int NWAVES = 8;

constexpr int DM = 2048, NBATCH = 4, SEQ = 2048, NMETA = 16, DBATCH = 128, DSEQ = 8, PAST = 16384;
constexpr int NH = 8, DK = 256, DV = 512, RQK = 2048, RV = 4096, NRI = 2 * RQK + 2 * RV  , NCI = 4 * DM  ;
constexpr int ROW_S0 = NBATCH * SEQ  , ROW_M0 = ROW_S0 + DBATCH * DSEQ  , M_REAL = ROW_M0 + NMETA  , M_PAD = 9472  ;
constexpr int NPOS = NMETA + SEQ + DSEQ;
constexpr float LN_EPS = 1e-5f, GN_EPS = 1e-6f;
constexpr int LDP = 64, LD_X = DM + LDP  , LD_A2 = RV + LDP  , LD_PROJ = NRI + LDP  , LD_Y = RV + LDP  ;
constexpr float DN_ALPHA = 1.681792830507429f;
constexpr size_t O_YP = 0, O_YS = O_YP + (size_t)NBATCH * SEQ * DM, O_SRP = O_YS + (size_t)DBATCH * DSEQ * DM, O_SRS = O_SRP + (size_t)2 * NBATCH * NH * DK * DV,
                 O_SCP = O_SRS + (size_t)2 * DBATCH * NH * DK * DV, O_SCS = O_SCP + (size_t)2 * NBATCH * 2 * DM, O_END = O_SCS + (size_t)2 * DBATCH * 2 * DM;

constexpr size_t MiB = 1u << 20;
constexpr size_t WS_CTL = 0, CTL_ZERO_BYTES = 64 * 1024;
constexpr size_t WS_WRI = 2 * MiB;
constexpr size_t WS_WRO = WS_WRI + (size_t)2 * NRI * LD_X * 2;
constexpr size_t WS_WCI = WS_WRO + (size_t)2 * DM * LD_A2 * 2;
constexpr size_t WS_WCO = WS_WCI + (size_t)2 * NCI * LD_X * 2;
constexpr size_t WS_ROPE = WS_WCO + (size_t)2 * DM * LD_X * 2;
constexpr size_t WS_XF = WS_ROPE + 4 * MiB;
constexpr size_t WS_XB = WS_XF + (size_t)M_PAD * DM * 4;
constexpr size_t WS_PROJ = WS_XB + (size_t)M_PAD * LD_X * 2;
constexpr size_t WS_A2 = WS_PROJ + (size_t)M_PAD * LD_PROJ * 2;
constexpr size_t WS_H = WS_A2 + (size_t)M_PAD * LD_A2 * 2;
constexpr size_t WS_YF = WS_H + (size_t)M_PAD * DM * 4;
constexpr size_t WS_PART = WS_YF + (size_t)M_PAD * RV * 4;
constexpr int TAIL_KS = 4;
#ifndef MK_DEFER_CVT
#define MK_DEFER_CVT 1
#endif
constexpr int W_ALL = 0xFF, W_IN_PROLOGUE = MK_DEFER_CVT ? 0x03 : W_ALL;
constexpr size_t WS_END = WS_PART + (size_t)TAIL_KS * (M_PAD - ROW_S0) * DM * 4;
constexpr int CW_QUEUE = 1024;
constexpr int CW_BAR = 4096;

constexpr int RING_OFF = 0, RING_BYTES = 139264;
constexpr int LDSCTL_OFF = RING_BYTES, MISC_OFF = LDSCTL_OFF + 320;
constexpr int LDS_BYTES = 147456;

#define GAS __attribute__((address_space(1)))
#define LAS __attribute__((address_space(3)))
typedef unsigned short bf16;
typedef unsigned v4u __attribute__((ext_vector_type(4)));
typedef unsigned v2u __attribute__((ext_vector_type(2)));
typedef float f32x4 __attribute__((ext_vector_type(4)));
typedef GAS unsigned gu32;
#define RLX_AGENT __ATOMIC_RELAXED, __HIP_MEMORY_SCOPE_AGENT
#define LDS_WAIT() asm volatile("s_waitcnt lgkmcnt(0)" ::: "memory")
#define VM_WAIT() asm volatile("s_waitcnt vmcnt(0)" ::: "memory")
__device__ __forceinline__ unsigned f2bf(float f) { unsigned u = __builtin_bit_cast(unsigned, f); return (u + 0x7fffu + ((u >> 16) & 1u)) >> 16; }
__device__ __forceinline__ unsigned pk2(float lo, float hi) { return f2bf(lo) | (f2bf(hi) << 16); }
__device__ __forceinline__ float bf_lo(unsigned w) { return __builtin_bit_cast(float, w << 16); }
__device__ __forceinline__ float bf_hi(unsigned w) { return __builtin_bit_cast(float, w & 0xffff0000u); }
__device__ __forceinline__ float bf2f(bf16 b) { return __builtin_bit_cast(float, ((unsigned)b) << 16); }

#define XB_TMO      128
#define XB_XCNT(j)  (256  + 64 * (j))
#define XB_XSUB(j)  (1280 + 64 * (j))
#define XB_XGEN(j)  (2304 + 64 * (j))
#define XB_TOP      3328
#define XB_TOPGEN   3392
#define XCD_BAR_WORDS 3456
#define XB_SPIN_CAP (1u << 20)

__device__ __forceinline__ unsigned xb_ld(unsigned* p)              { return __hip_atomic_load(p, __ATOMIC_RELAXED, __HIP_MEMORY_SCOPE_AGENT); }
__device__ __forceinline__ unsigned xb_add(unsigned* p, unsigned v) { return __hip_atomic_fetch_add(p, v, __ATOMIC_RELAXED, __HIP_MEMORY_SCOPE_AGENT); }
__device__ __forceinline__ unsigned xb_xcc_id() { return (unsigned)__builtin_amdgcn_s_getreg((3 << 11) | 20) & 0xFu; }
#define XB_SPIN(cond, bar) do { unsigned _sp = 0; while (cond) { __builtin_amdgcn_s_sleep(1); \
    if ((++_sp & 255u) == 0u) { if (xb_ld(&(bar)[XB_TMO])) break; if (_sp > XB_SPIN_CAP) { atomicAdd(&(bar)[XB_TMO], 1u); break; } } } } while (0)

struct XcdBarrier { unsigned* bar; unsigned x; volatile LAS unsigned* st; };

__device__ __forceinline__ XcdBarrier xcd_barrier_post(unsigned* bar, volatile LAS unsigned* st) {
    XcdBarrier b; b.bar = bar; b.x = xb_xcc_id(); b.st = st;
    if (threadIdx.x == 0) (void)xb_add(&bar[XB_XCNT(b.x)], 1u);
    return b;
}
__device__ __forceinline__ void xcd_barrier_complete(unsigned* bar, unsigned x, unsigned& nloc, unsigned& nx) {
    const unsigned G = gridDim.x * gridDim.y * gridDim.z;
    unsigned sum, cnt, mine, sp = 0u;
    for (;;) {
        sum = 0u; cnt = 0u; mine = 0u;
#pragma unroll
        for (unsigned j = 0; j < 16; ++j) { const unsigned c = xb_ld(&bar[XB_XCNT(j)]); sum += c; cnt += (c > 0u) ? 1u : 0u; mine = (j == x) ? c : mine; }
        if (sum == G) break;
        __builtin_amdgcn_s_sleep(1);
        if ((++sp & 255u) == 0u) { if (xb_ld(&bar[XB_TMO])) break; if (sp > XB_SPIN_CAP) { atomicAdd(&bar[XB_TMO], 1u); break; } }
    }
    nloc = mine > 0u ? mine : 1u; nx = cnt > 0u ? cnt : 1u;
}
__device__ __forceinline__ void xcd_barrier(const XcdBarrier& b) {
    asm volatile("s_waitcnt vmcnt(0)" ::: "memory");
    __syncthreads();
    if (threadIdx.x == 0) {
        unsigned* bar = b.bar;
        __builtin_amdgcn_s_waitcnt(0);
        unsigned nloc = b.st[0], nx = b.st[1];
        if (nloc == 0u) { xcd_barrier_complete(bar, b.x, nloc, nx); b.st[0] = nloc; b.st[1] = nx; }
        const unsigned old = xb_add(&bar[XB_XSUB(b.x)], 1u);
        const unsigned gen = old / nloc;
        if (old + 1u == (gen + 1u) * nloc) {
            __builtin_amdgcn_fence(__ATOMIC_RELEASE, "agent");
            asm volatile("s_waitcnt vmcnt(0)" ::: "memory");
            const unsigned og = xb_add(&bar[XB_TOP], 1u);
            const unsigned tg = og / nx;
            if (og + 1u == (tg + 1u) * nx) xb_add(&bar[XB_TOPGEN], 1u);
            else XB_SPIN(xb_ld(&bar[XB_TOPGEN]) == tg, bar);
            __builtin_amdgcn_fence(__ATOMIC_ACQUIRE, "agent");
            xb_add(&bar[XB_XGEN(b.x)], 1u);
            asm volatile("s_waitcnt vmcnt(0)" ::: "memory");
        } else {
            XB_SPIN(xb_ld(&bar[XB_XGEN(b.x)]) == gen, bar);
            __builtin_amdgcn_fence(__ATOMIC_ACQUIRE, "agent");
            asm volatile("s_waitcnt vmcnt(0)" ::: "memory");
        }
    }
    __syncthreads();
}

struct Frame {
    LAS unsigned char* lds;
    volatile LAS unsigned* MISC;
    gu32* ctl;
    int tid, lane, wave, vcu, G;
    const float *x_prompt, *x_sample, *state_ret, *state_conv, *meta, *w_ret_in, *w_ret_out, *w_conv_in, *conv_w, *w_conv_out, *ln_g, *ln_b;
    float* out;
    bf16 *Wri, *Wro, *Wci, *Wco, *XB, *PROJ, *A2;
    float *YF, *ROPE, *PART; bf16 *YB, *HB, *QT;
};
__device__ __forceinline__ float wave_sum(float v) {
#pragma unroll
    for (int o = 1; o < 64; o <<= 1) v += __shfl_xor(v, o);
    return v;
}
__device__ __forceinline__ int row_pos_idx(int row) { return row < ROW_S0 ? (row & (SEQ - 1)) + NMETA : (row < ROW_M0 ? NMETA + SEQ + ((row - ROW_S0) & (DSEQ - 1)) : (row < M_REAL ? row - ROW_M0 : 0)); }

__host__ __device__ __forceinline__ int conv_col_perm(int n) { const int g = n >> 11, e = n & 2047, pn = e >> 6, el = e & 63; return 256 * pn + 128 * (g >> 1) + 32 * (el >> 4) + 8 * ((el >> 2) & 3) + 4 * (g & 1) + (el & 3); }
template <bool CPERM = false> __device__ __forceinline__ void p0_transpose_item(const float* W, int K, int N, bf16* WT, int ldw, LAS float* scr, int item, int lane) {
    const int nblk = N / 32, kb = item / nblk, nb = item % nblk, k0 = 64 * kb, n0 = 32 * nb;
#pragma unroll 8
    for (int i = 0; i < 32; ++i) { const int kk = 2 * i + (lane >> 5); scr[kk * 33 + (lane & 31)] = W[(size_t)(k0 + kk) * N + n0 + (lane & 31)]; }
    LDS_WAIT(); asm volatile("" ::: "memory");
    const int c = lane & 7;
#pragma unroll
    for (int j = 0; j < 4; ++j) { const int n = (lane >> 3) + 8 * j; const LAS float* s = scr + (8 * c) * 33 + n;
        v4u o; o.x = pk2(s[0 * 33], s[1 * 33]); o.y = pk2(s[2 * 33], s[3 * 33]); o.z = pk2(s[4 * 33], s[5 * 33]); o.w = pk2(s[6 * 33], s[7 * 33]);
        *(GAS v4u*)(WT + (size_t)(CPERM ? conv_col_perm(n0 + n) : n0 + n) * ldw + k0 + 8 * c) = o; }
    LDS_WAIT(); asm volatile("" ::: "memory");
}
__device__ __forceinline__ void sincos_d(float angf, float& s_out, float& c_out) {
    const double a = (double)angf;
    const double kq = rint(a * 0.63661977236758134308);
    double r = fma(-kq, 1.57079632679489655800e+00, a); r = fma(-kq, 6.12323399573676603587e-17, r);
    const double r2 = r * r;
    double sp = -7.6471637318198164759e-13; sp = fma(sp, r2, 1.6059043836821614599e-10); sp = fma(sp, r2, -2.5052108385441718775e-08); sp = fma(sp, r2, 2.7557319223985890653e-06);
    sp = fma(sp, r2, -1.9841269841269841270e-04); sp = fma(sp, r2, 8.3333333333333333333e-03); sp = fma(sp, r2, -1.6666666666666666667e-01); const double sn = fma(sp * r2, r, r);
    double cp = 4.7794773323873852974e-14; cp = fma(cp, r2, -1.1470745597729724714e-11); cp = fma(cp, r2, 2.0876756987868098979e-09); cp = fma(cp, r2, -2.7557319223985890653e-07);
    cp = fma(cp, r2, 2.4801587301587301587e-05); cp = fma(cp, r2, -1.3888888888888888889e-03); cp = fma(cp, r2, 4.1666666666666666667e-02); cp = fma(cp, r2, -0.5); const double cs = fma(cp, r2, 1.0);
    const int q = ((int)kq) & 3;
    const double S = (q == 0) ? sn : (q == 1) ? cs : (q == 2) ? -sn : -cs;
    const double C = (q == 0) ? cs : (q == 1) ? -sn : (q == 2) ? -cs : sn;
    s_out = (float)S; c_out = (float)C;
}

template <int MASK> __device__ __forceinline__ void convert_weights(Frame& F, int gw, int nw) {
    LAS float* scr = (LAS float*)(F.lds + RING_OFF + F.wave * 16384);
    constexpr int I_RI = (DM / 64) * (NRI / 32), I_RO = (RV / 64) * (DM / 32), I_CI = (DM / 64) * (NCI / 32), I_CO = (DM / 64) * (DM / 32);
    int lane = F.lane; asm volatile("" : "+v"(lane));
#pragma unroll
    for (int j = 0; j < 2; ++j) {
        if (MASK & (1 << (4 * j + 0))) for (int r = gw; r < I_RI; r += nw) p0_transpose_item(F.w_ret_in + (size_t)j * DM * NRI, DM, NRI, F.Wri + (size_t)j * NRI * LD_X, LD_X, scr, r, lane);
        if (MASK & (1 << (4 * j + 1))) for (int r = gw; r < I_RO; r += nw) p0_transpose_item(F.w_ret_out + (size_t)j * RV * DM, RV, DM, F.Wro + (size_t)j * DM * LD_A2, LD_A2, scr, r, lane);
        if (MASK & (1 << (4 * j + 2))) for (int r = gw; r < I_CI; r += nw) p0_transpose_item<true>(F.w_conv_in + (size_t)j * DM * NCI, DM, NCI, F.Wci + (size_t)j * NCI * LD_X, LD_X, scr, r, lane);
        if (MASK & (1 << (4 * j + 3))) for (int r = gw; r < I_CO; r += nw) p0_transpose_item(F.w_conv_out + (size_t)j * DM * DM, DM, DM, F.Wco + (size_t)j * DM * LD_X, LD_X, scr, r, lane);
    }
}
template <int MASK> __device__ __forceinline__ void convert_by_idle(Frame& F, int n_busy) {
    const int c = (int)blockIdx.x;
    if (MASK != 0 && c >= n_busy && F.G == 256) { F.lane = (int)__builtin_amdgcn_mbcnt_hi(~0u, __builtin_amdgcn_mbcnt_lo(~0u, 0u)); convert_weights<MASK>(F, (c - n_busy) * NWAVES + F.wave, (F.G - n_busy) * NWAVES); }
}
__device__ __forceinline__ void p0_prologue(Frame& F, const float* freq) {
    const int gw = F.vcu * NWAVES + F.wave, NGW = F.G * NWAVES;
    if (F.G == 256) convert_weights<W_IN_PROLOGUE>(F, gw, NGW); else convert_weights<W_ALL>(F, gw, NGW);
    for (int m = gw; m < M_PAD; m += NGW) {
        const float* src = m < ROW_S0 ? F.x_prompt + (size_t)m * DM : (m < ROW_M0 ? F.x_sample + (size_t)(m - ROW_S0) * DM : (m < M_REAL ? F.meta + (size_t)(m - ROW_M0) * DM : nullptr));
        v2u* xb = (v2u*)(F.XB + (size_t)m * LD_X) + F.lane;
#pragma unroll
        for (int j = 0; j < 8; ++j) { const f32x4 v = src ? ((const f32x4*)src)[F.lane + 64 * j] : (f32x4){0.f, 0.f, 0.f, 0.f}; v2u o; o.x = pk2(v.x, v.y); o.y = pk2(v.z, v.w); xb[64 * j] = o; }
    }
    const int gt = F.vcu * NWAVES * 64 + F.tid, NGT = F.G * NWAVES * 64;
    for (int i = gt; i < NPOS * 128; i += NGT) {
        const int p = i >> 7, d = i & 127; const int pos = p < NMETA + SEQ ? p : PAST + (p - (NMETA + SEQ));
        const float ang = (float)pos * freq[d]; float s, c; sincos_d(ang, s, c);
        F.ROPE[i] = c; F.ROPE[NPOS * 128 + i] = s;
    }
    if (gt < 128) { float s, c; sincos_d(16.0f * freq[gt], s, c); F.ROPE[2 * NPOS * 128 + gt] = c; F.ROPE[2 * NPOS * 128 + 128 + gt] = s; }
}

struct EpiResBf16 {
    static constexpr bool PERM = true, AFTER_DRAIN = false;
    bf16* C; const bf16* R; float* P; float alpha;
    __device__ __forceinline__ void operator()(const pg8::f32x4 (&acc)[2][2][4][2], const pg8::Unit& u, int wr, int wc, int fr, int fq) const {
        const int row0 = u.pm * pg8::BM + wr * 64 + fr, col0 = pg8::unit_pn(u) * pg8::BM + wc * 32 + 8 * fq, part = pg8::unit_part(u);
        if (part < 0) {
            v4u rr[2][4][2];
#pragma unroll
            for (int ai = 0; ai < 2; ++ai)
#pragma unroll
                for (int m = 0; m < 4; ++m)
#pragma unroll
                    for (int bj = 0; bj < 2; ++bj) rr[ai][m][bj] = *(const v4u*)(R + (size_t)(row0 + ai * pg8::HALF + m * 16) * LD_X + col0 + bj * pg8::HALF);
            asm volatile("" ::: "memory");
#pragma unroll
            for (int ai = 0; ai < 2; ++ai)
#pragma unroll
                for (int m = 0; m < 4; ++m) { const size_t off = (size_t)(row0 + ai * pg8::HALF + m * 16) * LD_X + col0;
#pragma unroll
                    for (int bj = 0; bj < 2; ++bj) { const v4u r = rr[ai][m][bj];
                        const pg8::f32x4 v0 = acc[ai][bj][m][0] + (pg8::f32x4){bf_lo(r.x), bf_hi(r.x), bf_lo(r.y), bf_hi(r.y)} * alpha, v1 = acc[ai][bj][m][1] + (pg8::f32x4){bf_lo(r.z), bf_hi(r.z), bf_lo(r.w), bf_hi(r.w)} * alpha;
                        pg8::u32x4 w; w.x = pg8::cvt_pk_bf16(v0[0], v0[1]); w.y = pg8::cvt_pk_bf16(v0[2], v0[3]); w.z = pg8::cvt_pk_bf16(v1[0], v1[1]); w.w = pg8::cvt_pk_bf16(v1[2], v1[3]);
                        *(pg8::u32x4*)(C + off + bj * pg8::HALF) = w; } }
        } else {
            bf16* Pp = (bf16*)P + (size_t)part * (M_PAD - ROW_S0) * DM;
#pragma unroll
            for (int ai = 0; ai < 2; ++ai)
#pragma unroll
                for (int m = 0; m < 4; ++m) { const size_t off = (size_t)(row0 - ROW_S0 + ai * pg8::HALF + m * 16) * DM + col0;
#pragma unroll
                    for (int bj = 0; bj < 2; ++bj) { const pg8::f32x4 v0 = acc[ai][bj][m][0], v1 = acc[ai][bj][m][1];
                        pg8::u32x4 w; w.x = pg8::cvt_pk_bf16(v0[0], v0[1]); w.y = pg8::cvt_pk_bf16(v0[2], v0[3]); w.z = pg8::cvt_pk_bf16(v1[0], v1[1]); w.w = pg8::cvt_pk_bf16(v1[2], v1[3]);
                        *(pg8::u32x4*)(Pp + off + bj * pg8::HALF) = w; } }
        }
    }
};

struct Args { const float* in[12]; float* out; unsigned char* ws; float freq[128]; int ph_lo, ph_hi; };
extern __shared__ __attribute__((aligned(16))) unsigned char dyn_lds_base[];
__device__ __forceinline__ f32x4 row_ror1(const f32x4 v) { f32x4 r;
#pragma unroll
    for (int j = 0; j < 4; ++j) { const float t = v[j]; r[j] = __int_as_float(__builtin_amdgcn_update_dpp(0, __float_as_int(t), 0x121, 0xf, 0xf, false)); }
    return r; }
__device__ __forceinline__ f32x4 row_ror2(const f32x4 v) { f32x4 r;
#pragma unroll
    for (int j = 0; j < 4; ++j) { const float t = v[j]; r[j] = __int_as_float(__builtin_amdgcn_update_dpp(0, __float_as_int(t), 0x122, 0xf, 0xf, false)); }
    return r; }
struct EpiConvGate {
    static constexpr bool PERM = true, AFTER_DRAIN = false;
    int lj;
    __device__ __forceinline__ void operator()(const pg8::f32x4 (&acc)[2][2][4][2], const pg8::Unit& u, int wr, int wc, int fr_, int fq_) const {
        int fr = fr_, fq = fq_; asm volatile("" : "+v"(fr), "+v"(fq));
        const int row0 = u.pm * pg8::BM + wr * 64 + fr, e0 = 64 * u.pn + 16 * wc + 4 * fq;
        const Args* ka = (const Args*)__builtin_amdgcn_kernarg_segment_ptr(); asm volatile("" : "+s"(ka));
        unsigned char* wsb = ka->ws; bf16* O = (bf16*)(wsb + WS_PROJ); bf16* A = (bf16*)(wsb + WS_A2);
        const float* cw = ka->in[8] + (size_t)lj * 3 * DM; const float* sc = ka->in[3] + (size_t)lj * DBATCH * 2 * DM;
        float* sp = ka->out + O_SCP + (size_t)lj * NBATCH * 2 * DM; float* ss = ka->out + O_SCS + (size_t)lj * DBATCH * 2 * DM;
        LAS float* xl = (LAS float*)(dyn_lds_base + RING_OFF + 131072);
        if (u.pm < ROW_S0 / pg8::BM) {
            const pg8::f32x4 w0 = *(const pg8::f32x4*)(cw + e0), w1 = *(const pg8::f32x4*)(cw + DM + e0), w2 = *(const pg8::f32x4*)(cw + 2 * DM + e0);
            pg8::f32x4 uu[2][4];
#pragma unroll
            for (int ai = 0; ai < 2; ++ai)
#pragma unroll
                for (int m = 0; m < 4; ++m) uu[ai][m] = acc[ai][0][m][1] * acc[ai][1][m][0];
            if (fr >= 14) {
#pragma unroll
                for (int ai = 0; ai < 2; ++ai) *(LAS pg8::f32x4*)(xl + (size_t)(((((wr * 4 + wc) * 2 + ai) * 2 + (fr - 14)) * 4 + fq) * 4)) = uu[ai][3];
            }
            { const int t = (row0 + pg8::HALF + 48) & (SEQ - 1);
              if (t >= SEQ - 2) *(pg8::f32x4*)(sp + ((size_t)((row0 + pg8::HALF + 48) >> 11) * 2 + (t - (SEQ - 2))) * DM + e0) = uu[1][3]; }
            LDS_WAIT(); __builtin_amdgcn_s_barrier(); asm volatile("" ::: "memory");
#pragma unroll
            for (int ai = 0; ai < 2; ++ai) {
                const int B = 2 * ai + wr;
                pg8::f32x4 P = {0.f, 0.f, 0.f, 0.f};
                if (B > 0 && fr >= 14) P = *(const LAS pg8::f32x4*)(xl + (size_t)((((((1 - wr) * 4 + wc) * 2 + (wr ? ai : ai - 1)) * 2 + (fr - 14)) * 4 + fq) * 4));
#pragma unroll
                for (int m = 0; m < 4; ++m) { const int row = row0 + ai * pg8::HALF + m * 16;
                    const pg8::f32x4 U = uu[ai][m], Pm = m == 0 ? P : uu[ai][m - 1];
                    const pg8::f32x4 a1 = row_ror1(U), b1 = row_ror1(Pm), a2 = row_ror2(U), b2 = row_ror2(Pm);
                    const pg8::f32x4 u1 = fr >= 1 ? a1 : b1, u2 = fr >= 2 ? a2 : b2;
                    const pg8::f32x4 b = acc[ai][0][m][0], z = acc[ai][1][m][1]; pg8::f32x4 g2, r;
#pragma unroll
                    for (int j = 0; j < 4; ++j) { g2[j] = z[j] * __builtin_amdgcn_rcpf(1.0f + __expf(-z[j])) * b[j]; r[j] = g2[j] * (w0[j] * u2[j] + w1[j] * u1[j] + w2[j] * U[j]); }
                    v2u w; w.x = pg8::cvt_pk_bf16(r[0], r[1]); w.y = pg8::cvt_pk_bf16(r[2], r[3]); if (!(B == 0 && m == 0 && fr < 2)) *(v2u*)(A + (size_t)row * LD_X + e0) = w;
                    if ((B == 0 && m == 0 && fr < 2) || (B == 3 && m == 3 && fr >= 14)) { bf16* rp = O + (size_t)row * LD_PROJ + e0;
                        w.x = pg8::cvt_pk_bf16(U[0], U[1]); w.y = pg8::cvt_pk_bf16(U[2], U[3]); *(v2u*)rp = w;
                        w.x = pg8::cvt_pk_bf16(g2[0], g2[1]); w.y = pg8::cvt_pk_bf16(g2[2], g2[3]); *(v2u*)(rp + DM) = w; }
                }
            }
            return;
        }
        const pg8::f32x4 w0 = *(const pg8::f32x4*)(cw + e0), w1 = *(const pg8::f32x4*)(cw + DM + e0), w2 = *(const pg8::f32x4*)(cw + 2 * DM + e0);
        if (u.pm < ROW_M0 / pg8::BM) {
            const int s = fr & 7;
#pragma unroll
            for (int ai = 0; ai < 2; ++ai) {
                pg8::f32x4 st1[4], st0[4];
#pragma unroll
                for (int m = 0; m < 4; ++m) { const int sb = (row0 + ai * pg8::HALF + m * 16 - ROW_S0) >> 3; const float* sp_ = sc + (unsigned)(sb * 2 * DM + e0);
                    st1[m] = (pg8::f32x4){0.f, 0.f, 0.f, 0.f}; st0[m] = st1[m];
                    if (s < 2) st1[m] = *(const pg8::f32x4*)(sp_ + DM);
                    if (s < 1) st0[m] = *(const pg8::f32x4*)sp_; }
                asm volatile("" ::: "memory");
#pragma unroll
                for (int m = 0; m < 4; ++m) { const int row = row0 + ai * pg8::HALF + m * 16;
                    const pg8::f32x4 b = acc[ai][0][m][0], z = acc[ai][1][m][1], U = acc[ai][0][m][1] * acc[ai][1][m][0];
                    const pg8::f32x4 a1 = row_ror1(U), a2 = row_ror2(U);
                    const pg8::f32x4 u1 = s >= 1 ? a1 : st1[m], u2 = s >= 2 ? a2 : (s == 1 ? st1[m] : st0[m]);
                    pg8::f32x4 r;
#pragma unroll
                    for (int j = 0; j < 4; ++j) { const float g2 = z[j] * __builtin_amdgcn_rcpf(1.0f + __expf(-z[j])) * b[j]; r[j] = g2 * (w0[j] * u2[j] + w1[j] * u1[j] + w2[j] * U[j]); }
                    v2u w; w.x = pg8::cvt_pk_bf16(r[0], r[1]); w.y = pg8::cvt_pk_bf16(r[2], r[3]); *(v2u*)(A + (unsigned)(row * LD_X + e0)) = w;
                    if (s >= DSEQ - 2) *(pg8::f32x4*)(ss + (unsigned)((((row - ROW_S0) >> 3) * 2 + (s - (DSEQ - 2))) * DM + e0)) = U; }
            }
            return;
        }
#pragma unroll
        for (int ai = 0; ai < 2; ++ai)
#pragma unroll
            for (int m = 0; m < 4; ++m) { const int row = row0 + ai * pg8::HALF + m * 16;
                const pg8::f32x4 b = acc[ai][0][m][0], c = acc[ai][0][m][1], v = acc[ai][1][m][0], z = acc[ai][1][m][1];
                const pg8::f32x4 uu = c * v; pg8::f32x4 g2, r;
                const pg8::f32x4 a1 = row_ror1(uu), a2 = row_ror2(uu);
#pragma unroll
                for (int j = 0; j < 4; ++j) { g2[j] = z[j] * __builtin_amdgcn_rcpf(1.0f + __expf(-z[j])) * b[j];
                    r[j] = row < M_REAL ? g2[j] * (w0[j] * (fr >= 2 ? a2[j] : 0.f) + w1[j] * (fr >= 1 ? a1[j] : 0.f) + w2[j] * uu[j]) : 0.f; }
                bf16* rp = O + (size_t)row * LD_PROJ + e0;
                v2u w; w.x = pg8::cvt_pk_bf16(uu[0], uu[1]); w.y = pg8::cvt_pk_bf16(uu[2], uu[3]); *(v2u*)rp = w;
                w.x = pg8::cvt_pk_bf16(g2[0], g2[1]); w.y = pg8::cvt_pk_bf16(g2[2], g2[3]); *(v2u*)(rp + DM) = w;
                w.x = pg8::cvt_pk_bf16(r[0], r[1]); w.y = pg8::cvt_pk_bf16(r[2], r[3]); *(v2u*)(A + (size_t)row * LD_X + e0) = w;
            }
    }
};

struct EpiRopeBf16 {
    static constexpr bool PERM = true, AFTER_DRAIN = false;
    pg8::bf16_t* O; int ldc; const float* rope; pg8::bf16_t* QT;
    __device__ __forceinline__ void operator()(const pg8::f32x4 (&acc)[2][2][4][2], const pg8::Unit& u, int wr, int wc, int fr, int fq) const {
        const int row0 = u.pm * pg8::BM + wr * 64 + fr, col0 = u.pn * pg8::BM + wc * 32 + 8 * fq;
        if (u.pn < 16) {
            const bool isq = u.pn < 8; const int d0 = wc * 32 + 8 * fq;
            const float lgh = log2f(1.0f - exp2f(-5.0f - (float)(u.pn & 7)));
            const bool prow = u.pm < ROW_S0 / pg8::BM;
            pg8::f32x4 C0 = {1.f, 1.f, 1.f, 1.f}, C1 = C0, S0 = {0.f, 0.f, 0.f, 0.f}, S1 = S0;
            if (prow) { const float* stp = rope + (size_t)2 * NPOS * 128 + d0; C0 = *(const pg8::f32x4*)stp; C1 = *(const pg8::f32x4*)(stp + 4); S0 = *(const pg8::f32x4*)(stp + 128); S1 = *(const pg8::f32x4*)(stp + 132); }
            pg8::f32x4 cb0[2], cb1[2], sb0[2], sb1[2];
#pragma unroll
            for (int ai = 0; ai < 2; ++ai) { const float* ct = rope + (size_t)row_pos_idx(row0 + ai * pg8::HALF) * 128 + d0; const float* st = ct + (size_t)NPOS * 128;
                cb0[ai] = *(const pg8::f32x4*)ct; cb1[ai] = *(const pg8::f32x4*)(ct + 4); sb0[ai] = *(const pg8::f32x4*)st; sb1[ai] = *(const pg8::f32x4*)(st + 4); }
#pragma unroll
            for (int ai = 0; ai < 2; ++ai) {
                pg8::f32x4 rc0 = cb0[ai], rc1 = cb1[ai], rs0 = sb0[ai], rs1 = sb1[ai];
#pragma unroll
                for (int m = 0; m < 4; ++m) { const int row = row0 + ai * pg8::HALF + m * 16;
                    if (m > 0) { const pg8::f32x4 t0 = rc0 * C0 - rs0 * S0, t1 = rc1 * C1 - rs1 * S1; rs0 = rs0 * C0 + rc0 * S0; rs1 = rs1 * C1 + rc1 * S1; rc0 = t0; rc1 = t1; }
                    const int ci = row < ROW_S0 ? (row & 127) : (row >= ROW_M0 && row < M_REAL ? 112 + (row - ROW_M0) : 0);
                    const float sc = isq ? 0.0625f * __builtin_amdgcn_exp2f(lgh * (float)ci) : __builtin_amdgcn_exp2f(-lgh * (float)ci);
                    const pg8::f32x4 c0 = rc0 * sc, c1 = rc1 * sc, s0 = rs0 * sc, s1 = rs1 * sc;
                    const pg8::f32x4 a0 = acc[ai][0][m][0], a1 = acc[ai][0][m][1], b0 = acc[ai][1][m][0], b1 = acc[ai][1][m][1];
                    const pg8::f32x4 x0 = a0 * c0 - b0 * s0, x1 = a1 * c1 - b1 * s1, y0 = a0 * s0 + b0 * c0, y1 = a1 * s1 + b1 * c1;
                    const bool toqt = isq && (row < ROW_S0 || row >= ROW_M0);
                    const int ci2 = row < ROW_S0 ? (row & 127) : 112 + (row - ROW_M0);
                    const size_t blk = row < ROW_S0 ? (size_t)(((row >> 11) * NH + (u.pn & 7)) * 16 + ((row & 2047) >> 7)) * 4 + (ci2 >> 5) : (size_t)NBATCH * NH * 16 * 4 + (row < M_REAL ? 0 : NH) + (u.pn & 7);
                    pg8::bf16_t* qb = QT + blk * 8192 + ((size_t)((2 * wc + (fq >> 1)) * 64 + (fq & 1) * 32 + (ci2 & 31))) * 8;
                    pg8::bf16_t* pp = O + (size_t)row * ldc + col0;
                    pg8::bf16_t* p1 = toqt ? qb : pp; pg8::bf16_t* p2 = toqt ? qb + 8 * 64 * 8 : pp + pg8::HALF;
                    pg8::u32x4 w; w.x = pg8::cvt_pk_bf16(x0[0], x0[1]); w.y = pg8::cvt_pk_bf16(x0[2], x0[3]); w.z = pg8::cvt_pk_bf16(x1[0], x1[1]); w.w = pg8::cvt_pk_bf16(x1[2], x1[3]);
                    *(pg8::u32x4*)p1 = w;
                    w.x = pg8::cvt_pk_bf16(y0[0], y0[1]); w.y = pg8::cvt_pk_bf16(y0[2], y0[3]); w.z = pg8::cvt_pk_bf16(y1[0], y1[1]); w.w = pg8::cvt_pk_bf16(y1[2], y1[3]);
                    *(pg8::u32x4*)p2 = w; }
            }
        } else {
#pragma unroll
            for (int ai = 0; ai < 2; ++ai)
#pragma unroll
                for (int m = 0; m < 4; ++m) { pg8::bf16_t* rowp = O + (size_t)(row0 + ai * pg8::HALF + m * 16) * ldc + col0;
#pragma unroll
                    for (int bj = 0; bj < 2; ++bj) { const pg8::f32x4 v0 = acc[ai][bj][m][0], v1 = acc[ai][bj][m][1];
                        pg8::u32x4 w; w.x = pg8::cvt_pk_bf16(v0[0], v0[1]); w.y = pg8::cvt_pk_bf16(v0[2], v0[3]); w.z = pg8::cvt_pk_bf16(v1[0], v1[1]); w.w = pg8::cvt_pk_bf16(v1[2], v1[3]);
                        *(pg8::u32x4*)(rowp + bj * pg8::HALF) = w; } }
        }
    }
};

typedef float f32x2 __attribute__((ext_vector_type(2)));
struct SamplePre { v4u qk, v, g; };
__device__ __forceinline__ void sample_prefetch(Frame& F, int b, int h, SamplePre& p) {
    const int l = F.tid >> 6, c8 = F.tid & 63; const bf16* pr = F.PROJ + (size_t)(ROW_S0 + b * DSEQ + l) * LD_PROJ;
    p.qk = *(const v4u*)(pr + (c8 < 32 ? 0 : RQK) + h * DK + (c8 & 31) * 8);
    p.v = *(const v4u*)(pr + 2 * RQK + h * DV + c8 * 8);
    p.g = *(const v4u*)(pr + 2 * RQK + RV + h * DV + c8 * 8);
}
template <int VAR = 0, int PF = 8> __device__ __forceinline__ void retention_sample_unit(Frame& F, int lj, int b, int h, const SamplePre& pre) {
    LAS float* kq = (LAS float*)(F.lds + RING_OFF);
    LAS float* vl = (LAS float*)(F.lds + RING_OFF + 16384);
    LAS float* op = (LAS float*)(F.lds + RING_OFF + 32768);
    LAS float* Am = (LAS float*)(F.lds + RING_OFF + 98304);
    const float lg = log2f(1.0f - exp2f(-5.0f - (float)h));
    const int row0 = ROW_S0 + b * DSEQ;
    {
        const int l = F.tid >> 6, c8 = F.tid & 63; const bool isq = c8 < 32; const int d0 = (c8 & 31) * 8;
        const v4u w = pre.qk;
        const float sc = exp2f(lg * (isq ? (float)(l + 1) : (float)(7 - l)));
        const float e[8] = {bf_lo(w.x), bf_hi(w.x), bf_lo(w.y), bf_hi(w.y), bf_lo(w.z), bf_hi(w.z), bf_lo(w.w), bf_hi(w.w)};
#pragma unroll
        for (int j = 0; j < 8; ++j) kq[(d0 + j) * 16 + (isq ? 8 + l : l)] = e[j] * sc;
        const v4u wv = pre.v;
        LAS float* vd = vl + l * 512 + c8 * 8;
        vd[0] = bf_lo(wv.x); vd[1] = bf_hi(wv.x); vd[2] = bf_lo(wv.y); vd[3] = bf_hi(wv.y); vd[4] = bf_lo(wv.z); vd[5] = bf_hi(wv.z); vd[6] = bf_lo(wv.w); vd[7] = bf_hi(wv.w);
    }
    __syncthreads();
    {
        const int p = F.tid >> 3, part = F.tid & 7, l = p >> 3, m = p & 7; float a = 0.f;
        for (int d = part * 32; d < part * 32 + 32; ++d) a += kq[d * 16 + 8 + l] * kq[d * 16 + m];
        a += __shfl_xor(a, 1); a += __shfl_xor(a, 2); a += __shfl_xor(a, 4);
        if (part == 0) Am[p] = m <= l ? a * exp2f(-8.0f * lg) : 0.f;
    }
    const int rg = F.wave >> 1, vq = F.tid & 127;
    const float g8 = exp2f(8.0f * lg);
    f32x4 vv[8], o[8];
#pragma unroll
    for (int l = 0; l < 8; ++l) { vv[l] = *(const LAS f32x4*)(vl + l * 512 + 4 * vq); o[l] = (f32x4){0.f, 0.f, 0.f, 0.f}; }
    const size_t sbase = ((size_t)(lj * DBATCH + b) * NH + h) * DK * DV + (size_t)(rg * 64) * DV + 4 * vq;
    const f32x4* sp = (const f32x4*)(F.state_ret + sbase); f32x4* so = (f32x4*)(F.out + O_SRS + sbase);
    f32x4 buf[PF];
#pragma unroll
    for (int u = 0; u < PF; ++u) buf[u] = __builtin_nontemporal_load(sp + (size_t)u * (DV / 4));
    for (int i0 = 0; i0 < 64; i0 += PF) {
#pragma unroll
        for (int u = 0; u < PF; ++u) {
            const f32x4 s = buf[u];
            if (i0 + PF < 64) buf[u] = __builtin_nontemporal_load(sp + (size_t)(i0 + PF + u) * (DV / 4));
            if (VAR == 1) { o[0] += s; __builtin_nontemporal_store(s * g8, so + (size_t)(i0 + u) * (DV / 4)); continue; }
            if (VAR == 2) { o[0] += s; continue; }
            const LAS f32x4* kr = (const LAS f32x4*)(kq + (rg * 64 + i0 + u) * 16);
            const f32x4 k03 = kr[0], k47 = kr[1], q03 = kr[2], q47 = kr[3];
            o[0] += s * q03.x; o[1] += s * q03.y; o[2] += s * q03.z; o[3] += s * q03.w; o[4] += s * q47.x; o[5] += s * q47.y; o[6] += s * q47.z; o[7] += s * q47.w;
            f32x4 sn = s * g8;
            sn += vv[0] * k03.x; sn += vv[1] * k03.y; sn += vv[2] * k03.z; sn += vv[3] * k03.w; sn += vv[4] * k47.x; sn += vv[5] * k47.y; sn += vv[6] * k47.z; sn += vv[7] * k47.w;
            __builtin_nontemporal_store(sn, so + (size_t)(i0 + u) * (DV / 4));
        }
    }
#pragma unroll
    for (int l = 0; l < 8; ++l) *(LAS f32x4*)(op + (rg * 8 + l) * 512 + 4 * vq) = o[l];
    __syncthreads();
    {
        const int l = F.wave, v0 = 8 * F.lane; float y[8];
#pragma unroll
        for (int j = 0; j < 8; ++j) y[j] = 0.f;
#pragma unroll
        for (int r = 0; r < 4; ++r) { const f32x4 a = *(const LAS f32x4*)(op + (r * 8 + l) * 512 + v0), c = *(const LAS f32x4*)(op + (r * 8 + l) * 512 + v0 + 4);
            y[0] += a.x; y[1] += a.y; y[2] += a.z; y[3] += a.w; y[4] += c.x; y[5] += c.y; y[6] += c.z; y[7] += c.w; }
        for (int m = 0; m <= l; ++m) { const float am = Am[l * 8 + m]; const f32x4 a = *(const LAS f32x4*)(vl + m * 512 + v0), c = *(const LAS f32x4*)(vl + m * 512 + v0 + 4);
            y[0] += am * a.x; y[1] += am * a.y; y[2] += am * a.z; y[3] += am * a.w; y[4] += am * c.x; y[5] += am * c.y; y[6] += am * c.z; y[7] += am * c.w; }
        float s1 = 0.f;
#pragma unroll
        for (int j = 0; j < 8; ++j) s1 += y[j];
        const float mu = wave_sum(s1) * (1.f / DV); float s2 = 0.f;
#pragma unroll
        for (int j = 0; j < 8; ++j) { y[j] -= mu; s2 += y[j] * y[j]; }
        const float rs = 1.0f / sqrtf(wave_sum(s2) * (1.f / DV) + GN_EPS);
        const v4u gw4 = pre.g;
        const float g[8] = {bf_lo(gw4.x), bf_hi(gw4.x), bf_lo(gw4.y), bf_hi(gw4.y), bf_lo(gw4.z), bf_hi(gw4.z), bf_lo(gw4.w), bf_hi(gw4.w)};
        float r[8];
#pragma unroll
        for (int j = 0; j < 8; ++j) r[j] = g[j] / (1.0f + __expf(-g[j])) * (y[j] * rs);
        v4u w; w.x = pk2(r[0], r[1]); w.y = pk2(r[2], r[3]); w.z = pk2(r[4], r[5]); w.w = pk2(r[6], r[7]);
        *(v4u*)(F.A2 + (size_t)(row0 + l) * LD_A2 + h * DV + v0) = w;
    }
    __syncthreads();
}
typedef float f32x16 __attribute__((ext_vector_type(16)));
typedef short s16x8 __attribute__((ext_vector_type(8)));
typedef short s16x4 __attribute__((ext_vector_type(4)));
typedef short v4i16_t __attribute__((ext_vector_type(4)));
typedef __bf16 bf16x2_t __attribute__((ext_vector_type(2)));
__device__ __forceinline__ unsigned cvtpk(float lo, float hi) { const f32x2 v = {lo, hi}; return __builtin_bit_cast(unsigned, __builtin_convertvector(v, bf16x2_t)); }
__device__ __forceinline__ int crow(int r, int hk) { return (r & 3) + 8 * (r >> 2) + 4 * hk; }
__device__ __forceinline__ unsigned off_b(unsigned row, unsigned ch) { return 256u * row + 16u * (ch ^ (((row & 3u) << 2) | ((row >> 2) & 3u))); }
__device__ __forceinline__ unsigned offv(unsigned m, unsigned ch) { return 128u * m + 16u * (ch ^ (((m >> 1) & 1u) << 2)); }
__device__ __forceinline__ s16x4 tr_read(LAS unsigned char* p) { return __builtin_bit_cast(s16x4, __builtin_amdgcn_ds_read_tr16_b64_v4i16((LAS v4i16_t*)p)); }
__device__ __forceinline__ int tok_row(int c, int i, int b) { const int t = 128 * c + i - 112; return t < 0 ? -1 : (t < NMETA ? ROW_M0 + t : b * SEQ + (t - NMETA)); }
#define MFMA32(a, b, c) __builtin_amdgcn_mfma_f32_32x32x16_bf16((a), (b), (c), 0, 0, 0)
#define RP_LANES() int lane_ = (int)__builtin_amdgcn_mbcnt_hi(~0u, __builtin_amdgcn_mbcnt_lo(~0u, 0u)); asm volatile("" : "+v"(lane_)); const int lr = lane_ & 31, hk = lane_ >> 5, blk = (lane_ >> 4) & 1, q4 = (lane_ & 15) >> 2, p4 = lane_ & 3; const unsigned trsub = 8u * (p4 & 1); (void)lr; (void)hk; (void)blk; (void)q4; (void)trsub
#define RP_TID() int tid_ = (int)__builtin_amdgcn_mbcnt_hi(~0u, __builtin_amdgcn_mbcnt_lo(~0u, 0u)); asm volatile("" : "+v"(tid_)); tid_ += 64 * w
#define RP_SB() __builtin_amdgcn_sched_barrier(0)
__device__ __forceinline__ void rp_dma_kv(LAS unsigned char* KI, LAS unsigned char* VI, const bf16* Pk, const bf16* Pv, const void* zero16, int cc, int b, int w, int lane) {
#pragma unroll
    for (int i = 0; i < 8; ++i) { const int piece = w * 8 + i;
        const int dh = piece >> 5, r = 4 * (piece & 31) + (lane >> 4), pc = lane & 15, ch = pc ^ (((r & 3) << 2) | ((r >> 2) & 3));
        const int row = tok_row(cc, r, b);
        const void* g = row >= 0 ? (const void*)(Pk + (size_t)row * LD_PROJ + dh * 128 + 8 * ch) : zero16;
        __builtin_amdgcn_global_load_lds((const unsigned*)g, (LAS unsigned*)(KI + piece * 1024), 16, 0, 0); }
#pragma unroll
    for (int i = 0; i < 2; ++i) { const int piece = w * 2 + i;
        const int m = 8 * piece + (lane >> 3), pc = lane & 7, ch = pc ^ (((m >> 1) & 1) << 2);
        const int row = tok_row(cc, m, b);
        const void* g = row >= 0 ? (const void*)(Pv + (size_t)row * LD_PROJ + 8 * ch) : zero16;
        __builtin_amdgcn_global_load_lds((const unsigned*)g, (LAS unsigned*)(VI + piece * 1024), 16, 0, 0); }
}
template <int SKIP = 0> __device__ __forceinline__ void retention_prompt_mfma_unit(Frame& F, int lj, int uu) {
    LAS unsigned char* KI = F.lds + RING_OFF;
    LAS unsigned char* VI = F.lds + RING_OFF + 65536;
    LAS unsigned char* SI = F.lds + RING_OFF + 81920;
    LAS unsigned char* OT = F.lds + RING_OFF + 114688;
    const int vs = uu & 7, h = (uu >> 3) & 7, b = uu >> 6;
    const int w = F.wave;
    const int lb = w < 4 ? (w >> 1) : 3 - ((w - 4) >> 1), vb = w & 1;
    const float lg = log2f(1.0f - exp2f(-5.0f - (float)h));
    const bf16* Pk = F.PROJ + RQK + h * DK; const bf16* Pv = F.PROJ + 2 * RQK + h * DV + 64 * vs;
    { RP_TID(); for (int i = tid_; i < 32768 / 16; i += NWAVES * 64) *(LAS v4u*)(SI + 16 * i) = (v4u){0u, 0u, 0u, 0u}; }
    f32x16 Sacc[2];
#pragma unroll
    for (int r = 0; r < 16; ++r) { Sacc[0][r] = 0.f; Sacc[1][r] = 0.f; }
    s16x8 Qf[16], Qn[8];
    const void* zero16 = (const void*)((const unsigned char*)F.ctl + 8192);
    { RP_TID(); RP_LANES(); (void)tid_;
      rp_dma_kv(KI, VI, Pk, Pv, zero16, 0, b, w, lane_);
      { const bf16* q0 = F.QT + ((size_t)NBATCH * NH * 16 * 4 + h) * 8192 + lane_ * 8; const bool qv = lb == 3 && lr >= 16;
#pragma unroll
        for (int s = 0; s < 16; ++s) Qf[s] = qv ? *(const s16x8*)(q0 + s * 512) : (s16x8){0, 0, 0, 0, 0, 0, 0, 0}; }
    }
    asm volatile("s_waitcnt vmcnt(0)" ::: "memory");
    __syncthreads();
    for (int c = 0; c < 17; ++c) {
        if (c < 16 && !(SKIP & 8)) { RP_LANES();
          { const bf16* qn = F.QT + ((size_t)(((b * NH + h) * 16 + c) * 4 + lb)) * 8192 + lane_ * 8;
#pragma unroll
            for (int s = 0; s < 8; ++s) Qn[s] = *(const s16x8*)(qn + s * 512); }
        }
        RP_SB();
        f32x16 Oacc;
#pragma unroll
        for (int r = 0; r < 16; ++r) Oacc[r] = 0.f;
        for (int mb = 0; mb <= ((SKIP & 1) ? -1 : lb); ++mb) { RP_LANES();
            f32x16 Sc;
#pragma unroll
            for (int r = 0; r < 16; ++r) Sc[r] = 0.f;
            LAS unsigned char* krow = KI + 256 * (32 * mb + lr); const unsigned xr = ((lr & 3) << 2) | ((lr >> 2) & 3);
#pragma unroll
            for (int s = 0; s < 16; ++s) { const s16x8 a = *(const LAS s16x8*)(krow + (s >> 3) * 32768 + 16 * ((2 * (s & 7) + hk) ^ xr)); Sc = MFMA32(a, Qf[s], Sc); }
            if (mb == lb) {
#pragma unroll
                for (int r = 0; r < 16; ++r) Sc[r] = lr >= crow(r, hk) ? Sc[r] : 0.f;
            }
#pragma unroll
            for (int s2 = 0; s2 < 2; ++s2) {
                v4u pw; pw.x = cvtpk(Sc[8 * s2 + 0], Sc[8 * s2 + 1]); pw.y = cvtpk(Sc[8 * s2 + 2], Sc[8 * s2 + 3]); pw.z = cvtpk(Sc[8 * s2 + 4], Sc[8 * s2 + 5]); pw.w = cvtpk(Sc[8 * s2 + 6], Sc[8 * s2 + 7]);
                const s16x8 Pf = __builtin_bit_cast(s16x8, pw);
                const unsigned m0 = 32 * mb + 16 * s2 + 4 * hk + q4, chv = 4 * vb + 2 * blk + (p4 >> 1);
                const s16x4 lo = tr_read(VI + offv(m0, chv) + trsub), hi = tr_read(VI + offv(m0 + 8, chv) + trsub);
                const s16x8 Va = __builtin_shufflevector(lo, hi, 0, 1, 2, 3, 4, 5, 6, 7);
                Oacc = MFMA32(Va, Pf, Oacc);
            }
        }
        RP_SB();
        { RP_LANES();
            LAS unsigned char* kbase = KI + (w >> 2) * 32768 + trsub; const unsigned chk = 4 * (w & 3) + 2 * blk + (p4 >> 1);
            LAS unsigned char* vbase = VI + trsub; const unsigned chv = 2 * blk + (p4 >> 1);
#pragma unroll
            for (int s = 0; s < ((SKIP & 4) ? 0 : 8); ++s) {
                const unsigned mrow = 16 * s + 8 * hk + q4;
                const s16x4 k0 = tr_read(kbase + off_b(mrow, chk)), k1 = tr_read(kbase + off_b(mrow + 4, chk));
                const s16x8 Ka = __builtin_shufflevector(k0, k1, 0, 1, 2, 3, 4, 5, 6, 7);
#pragma unroll
                for (int v2 = 0; v2 < 2; ++v2) {
                    const s16x4 v0 = tr_read(vbase + offv(mrow, 4 * v2 + chv)), v1 = tr_read(vbase + offv(mrow + 4, 4 * v2 + chv));
                    const s16x8 Vb = __builtin_shufflevector(v0, v1, 0, 1, 2, 3, 4, 5, 6, 7);
                    Sacc[v2] = MFMA32(Ka, Vb, Sacc[v2]);
                }
            }
        }
        RP_SB();
        __syncthreads();
        if (c < 16 && !(SKIP & 16)) { RP_LANES(); rp_dma_kv(KI, VI, Pk, Pv, zero16, c + 1, b, w, lane_); }
        { RP_LANES();
            LAS unsigned char* srow = SI + 256 * (32 * vb + lr); const unsigned xr = ((lr & 3) << 2) | ((lr >> 2) & 3);
            if (!(SKIP & 2)) {
#pragma unroll
            for (int s = 0; s < 16; ++s) { const s16x8 a = *(const LAS s16x8*)(srow + (s >> 3) * 16384 + 16 * ((2 * (s & 7) + hk) ^ xr)); Oacc = MFMA32(a, Qf[s], Oacc); }
            }
          { LAS unsigned char* op = OT + 144 * (32 * lb + lr) + 2 * (32 * vb + 4 * hk);
#pragma unroll
            for (int g4 = 0; g4 < 4; ++g4) { v2u o; o.x = cvtpk(Oacc[4 * g4], Oacc[4 * g4 + 1]); o.y = cvtpk(Oacc[4 * g4 + 2], Oacc[4 * g4 + 3]); *(LAS v2u*)(op + 16 * g4) = o; } }
          if (c < 16 && !(SKIP & 8)) { const bf16* qn = F.QT + ((size_t)(((b * NH + h) * 16 + c) * 4 + lb)) * 8192 + lane_ * 8;
#pragma unroll
            for (int s = 8; s < 16; ++s) Qf[s] = *(const s16x8*)(qn + s * 512); }
        }
        RP_SB();
        asm volatile("s_waitcnt lgkmcnt(0)" ::: "memory"); __builtin_amdgcn_s_barrier(); asm volatile("" ::: "memory");
        { RP_TID();
#pragma unroll
          for (int i = 0; i < 2; ++i) { const int idx = tid_ + 512 * i, r = idx >> 3, ch = idx & 7; const int row = tok_row(c, r, b);
              if (row >= 0 && (c > 0 || b == 0)) *(v4u*)(F.YB + (size_t)row * LD_Y + h * DV + 64 * vs + 8 * ch) = *(const LAS v4u*)(OT + 144 * r + 16 * ch); } }
        { RP_LANES(); RP_TID();
          const float g128 = __builtin_amdgcn_exp2f(128.0f * lg);
#pragma unroll
          for (int r = 0; r < 16; ++r) { Sacc[0][r] *= g128; Sacc[1][r] *= g128; }
#pragma unroll
          for (int v2 = 0; v2 < 2; ++v2)
#pragma unroll
            for (int g4 = 0; g4 < 4; ++g4) { v2u o; o.x = cvtpk(Sacc[v2][4 * g4], Sacc[v2][4 * g4 + 1]); o.y = cvtpk(Sacc[v2][4 * g4 + 2], Sacc[v2][4 * g4 + 3]);
                *(LAS v2u*)(SI + (w >> 2) * 16384 + off_b(32 * v2 + lr, 4 * (w & 3) + g4) + 8 * hk) = o; }
          if (c < 16) {
#pragma unroll
            for (int s = 0; s < 8; ++s) Qf[s] = Qn[s];
          }
        }
        asm volatile("s_waitcnt vmcnt(0)" ::: "memory");
        __syncthreads();
    }
    { RP_LANES(); const float ginv = __builtin_amdgcn_exp2f(-lg);
      float* so = F.out + O_SRP + ((size_t)(lj * NBATCH + b) * NH + h) * DK * DV + 64 * vs + lr;
#pragma unroll
      for (int v2 = 0; v2 < 2; ++v2)
#pragma unroll
          for (int r = 0; r < 16; ++r) so[(size_t)(32 * w + crow(r, hk)) * DV + 32 * v2] = Sacc[v2][r] * ginv; }
    __syncthreads();
}
__device__ __forceinline__ void retention_phase(Frame& F, int lj, int what = 3) {
    const int half = F.G >> 1, me = F.vcu >> 1;
    if (what == 3 && F.G >= 2) {
        if (!(F.vcu & 1)) { for (int u = me; u < NBATCH * NH * 8; u += half) retention_prompt_mfma_unit(F, lj, u); }
        gu32* qhead = F.ctl + CW_QUEUE + 64 * lj;
        F.lane = (int)__builtin_amdgcn_mbcnt_hi(~0u, __builtin_amdgcn_mbcnt_lo(~0u, 0u)); asm volatile("" : "+v"(F.lane)); F.tid = F.wave * 64 + F.lane;
        SamplePre p0, p1;
        __syncthreads();
        if (F.tid == 0) F.MISC[16] = __hip_atomic_fetch_add(qhead, 1u, RLX_AGENT);
        __syncthreads();
        int u0 = (int)F.MISC[16];
        if (u0 < DBATCH * NH) sample_prefetch(F, u0 >> 3, u0 & 7, p0);
        while (u0 < DBATCH * NH) {
            __syncthreads();
            if (F.tid == 0) F.MISC[16] = __hip_atomic_fetch_add(qhead, 1u, RLX_AGENT);
            __syncthreads();
            const int u1 = (int)F.MISC[16];
            if (u1 < DBATCH * NH) sample_prefetch(F, u1 >> 3, u1 & 7, p1);
            retention_sample_unit(F, lj, u0 >> 3, u0 & 7, p0);
            u0 = u1; p0 = p1;
        }
        return;
    }
    if (what == 70) { if (!(F.vcu & 1)) for (int u = me; u < NBATCH * NH * 8; u += half) retention_prompt_mfma_unit(F, lj, u); return; }
    if (what == 71) { if (F.vcu & 1) for (int u = me; u < DBATCH * NH; u += half) { SamplePre pp; sample_prefetch(F, u >> 3, u & 7, pp); retention_sample_unit(F, lj, u >> 3, u & 7, pp); } return; }
    if (what >= 64) { for (int u = F.vcu; u < NBATCH * NH * 8; u += F.G) { if (what == 64) retention_prompt_mfma_unit<1>(F, lj, u); else if (what == 65) retention_prompt_mfma_unit<2>(F, lj, u); else if (what == 66) retention_prompt_mfma_unit<4>(F, lj, u); else if (what == 67) retention_prompt_mfma_unit<8>(F, lj, u); else if (what == 68) retention_prompt_mfma_unit<24>(F, lj, u); else retention_prompt_mfma_unit<0>(F, lj, u); } return; }
    if (what == 8) { for (int u = F.vcu; u < DBATCH * NH; u += F.G) { SamplePre pp; sample_prefetch(F, u >> 3, u & 7, pp); retention_sample_unit<1>(F, lj, u >> 3, u & 7, pp); } return; }
    if (what == 32) { if ((F.vcu & 3) == 3) for (int u = F.vcu >> 2; u < DBATCH * NH; u += F.G >> 2) { SamplePre pp; sample_prefetch(F, u >> 3, u & 7, pp); retention_sample_unit<1, 16>(F, lj, u >> 3, u & 7, pp); } return; }
    if (what == 16) { for (int u = F.vcu; u < DBATCH * NH; u += F.G) { SamplePre pp; sample_prefetch(F, u >> 3, u & 7, pp); retention_sample_unit<2>(F, lj, u >> 3, u & 7, pp); } return; }
    if (what & 1) for (int u = F.vcu; u < NBATCH * NH * 8; u += F.G) retention_prompt_mfma_unit(F, lj, u);
    F.lane = (int)__builtin_amdgcn_mbcnt_hi(~0u, __builtin_amdgcn_mbcnt_lo(~0u, 0u)); asm volatile("" : "+v"(F.lane)); F.tid = F.wave * 64 + F.lane;
    if (what & 2) for (int u = F.vcu; u < DBATCH * NH; u += F.G) { SamplePre pp; sample_prefetch(F, u >> 3, u & 7, pp); retention_sample_unit(F, lj, u >> 3, u & 7, pp); }
}

__device__ __forceinline__ void groupnorm_gate_phase(Frame& F) {
    const int gw = F.vcu * NWAVES + F.wave, NGW = F.G * NWAVES;
    for (int it = gw; it < M_PAD * NH; it += NGW) {
        const int row = it >> 3, h = it & 7;
        v4u* o = (v4u*)(F.A2 + (size_t)row * LD_A2 + h * DV) + F.lane;
        if (row >= ROW_S0 && row < ROW_M0) continue;
        if (row >= M_REAL) { *o = (v4u){0u, 0u, 0u, 0u}; continue; }
        const v4u yw = *((const v4u*)(F.YB + (size_t)row * LD_Y + h * DV) + F.lane);
        const f32x4 y0 = {bf_lo(yw.x), bf_hi(yw.x), bf_lo(yw.y), bf_hi(yw.y)}, y1 = {bf_lo(yw.z), bf_hi(yw.z), bf_lo(yw.w), bf_hi(yw.w)};
        const float mu = wave_sum((y0.x + y0.y) + (y0.z + y0.w) + (y1.x + y1.y) + (y1.z + y1.w)) * (1.f / DV);
        const f32x4 d0 = y0 - mu, d1 = y1 - mu;
        const float var = wave_sum((d0.x * d0.x + d0.y * d0.y) + (d0.z * d0.z + d0.w * d0.w) + (d1.x * d1.x + d1.y * d1.y) + (d1.z * d1.z + d1.w * d1.w)) * (1.f / DV);
        const float rs = 1.0f / sqrtf(var + GN_EPS);
        const v4u gw4 = *((const v4u*)(F.PROJ + (size_t)row * LD_PROJ + 2 * RQK + RV + h * DV) + F.lane);
        float g[8] = {bf_lo(gw4.x), bf_hi(gw4.x), bf_lo(gw4.y), bf_hi(gw4.y), bf_lo(gw4.z), bf_hi(gw4.z), bf_lo(gw4.w), bf_hi(gw4.w)};
        float yn[8] = {d0.x * rs, d0.y * rs, d0.z * rs, d0.w * rs, d1.x * rs, d1.y * rs, d1.z * rs, d1.w * rs};
        float r[8];
#pragma unroll
        for (int j = 0; j < 8; ++j) r[j] = g[j] / (1.0f + __expf(-g[j])) * yn[j];
        v4u w; w.x = pk2(r[0], r[1]); w.y = pk2(r[2], r[3]); w.z = pk2(r[4], r[5]); w.w = pk2(r[6], r[7]);
        *o = w;
    }
}

__device__ __forceinline__ void layernorm_phase(Frame& F, int layer, bool last) {
    const int gw = F.vcu * NWAVES + F.wave, NGW = F.G * NWAVES;
    for (int row = gw; row < M_PAD; row += NGW) {
        float v[4][8]; float s = 0.f;
        if (row < ROW_S0) {
            const v4u* hp = (const v4u*)(F.HB + (size_t)row * LD_X) + F.lane;
#pragma unroll
            for (int j = 0; j < 4; ++j) { const v4u w = hp[64 * j]; v[j][0] = bf_lo(w.x); v[j][1] = bf_hi(w.x); v[j][2] = bf_lo(w.y); v[j][3] = bf_hi(w.y); v[j][4] = bf_lo(w.z); v[j][5] = bf_hi(w.z); v[j][6] = bf_lo(w.w); v[j][7] = bf_hi(w.w); }
        } else {
            const v4u* xp = (const v4u*)(F.XB + (size_t)row * LD_X) + F.lane; const v4u* pp = (const v4u*)((const bf16*)F.PART + (size_t)(row - ROW_S0) * DM) + F.lane;
#pragma unroll
            for (int j = 0; j < 4; ++j) { const v4u w = xp[64 * j];
                f32x4 a0 = (f32x4){bf_lo(w.x), bf_hi(w.x), bf_lo(w.y), bf_hi(w.y)} * DN_ALPHA, a1 = (f32x4){bf_lo(w.z), bf_hi(w.z), bf_lo(w.w), bf_hi(w.w)} * DN_ALPHA;
#pragma unroll
                for (int k = 0; k < TAIL_KS; ++k) { const v4u q = pp[(size_t)k * (M_PAD - ROW_S0) * (DM / 8) + 64 * j];
                    a0 += (f32x4){bf_lo(q.x), bf_hi(q.x), bf_lo(q.y), bf_hi(q.y)}; a1 += (f32x4){bf_lo(q.z), bf_hi(q.z), bf_lo(q.w), bf_hi(q.w)}; }
                v[j][0] = a0.x; v[j][1] = a0.y; v[j][2] = a0.z; v[j][3] = a0.w; v[j][4] = a1.x; v[j][5] = a1.y; v[j][6] = a1.z; v[j][7] = a1.w; }
        }
#pragma unroll
        for (int j = 0; j < 4; ++j)
#pragma unroll
            for (int e = 0; e < 8; ++e) s += v[j][e];
        const float mean = wave_sum(s) * (1.f / DM); float s2 = 0.f;
#pragma unroll
        for (int j = 0; j < 4; ++j)
#pragma unroll
            for (int e = 0; e < 8; ++e) { v[j][e] -= mean; s2 += v[j][e] * v[j][e]; }
        const float rstd = 1.f / sqrtf(wave_sum(s2) * (1.f / DM) + LN_EPS);
        const f32x4* gp = (const f32x4*)(F.ln_g + (size_t)layer * DM) + 2 * F.lane; const f32x4* bp = (const f32x4*)(F.ln_b + (size_t)layer * DM) + 2 * F.lane;
        v4u* xb = (v4u*)(F.XB + (size_t)row * LD_X) + F.lane;
        f32x4* od = nullptr;
        if (last) { if (row < ROW_S0) od = (f32x4*)(F.out + O_YP + (size_t)row * DM) + 2 * F.lane; else if (row < ROW_M0) od = (f32x4*)(F.out + O_YS + (size_t)(row - ROW_S0) * DM) + 2 * F.lane; }
#pragma unroll
        for (int j = 0; j < 4; ++j) { const f32x4 g0 = gp[128 * j], g1 = gp[128 * j + 1], b0 = bp[128 * j], b1 = bp[128 * j + 1];
            const f32x4 y0 = (f32x4){v[j][0], v[j][1], v[j][2], v[j][3]} * rstd * g0 + b0, y1 = (f32x4){v[j][4], v[j][5], v[j][6], v[j][7]} * rstd * g1 + b1;
            if (last) { if (od) { od[128 * j] = y0; od[128 * j + 1] = y1; } }
            else { v4u o; o.x = pk2(y0.x, y0.y); o.y = pk2(y0.z, y0.w); o.z = pk2(y1.x, y1.y); o.w = pk2(y1.z, y1.w); xb[64 * j] = o; } }
    }
}

__device__ __forceinline__ void conv_fixup(Frame& F, int lj, int pm) {
    const float* cw = F.conv_w + (size_t)lj * 3 * DM;
    for (int it = F.tid; it < 2 * (DM / 8); it += NWAVES * 64) {
        const int e0 = (it & 255) * 8; const int row = pm * 256 + (it >> 8);
        v4u* o = (v4u*)(F.A2 + (size_t)row * LD_X + e0);
        if (row >= M_REAL) { *o = (v4u){0u, 0u, 0u, 0u}; continue; }
        int r1, r2;
        if (row < ROW_S0) { const int t = row & (SEQ - 1); r1 = t >= 1 ? row - 1 : ROW_M0 + 15; r2 = t >= 2 ? row - 2 : (t == 1 ? ROW_M0 + 15 : ROW_M0 + 14); }
        else if (row < ROW_M0) { const int s = (row - ROW_S0) & (DSEQ - 1); r1 = s >= 1 ? row - 1 : -3; r2 = s >= 2 ? row - 2 : (s == 1 ? -3 : -2); }
        else { const int j = row - ROW_M0; r1 = j >= 1 ? row - 1 : -1; r2 = j >= 2 ? row - 2 : -1; }
        float u0[8], u1[8], u2[8];
        const bf16* pr = F.PROJ + (size_t)row * LD_PROJ + e0;
        { const v4u w = *(const v4u*)pr; u0[0] = bf_lo(w.x); u0[1] = bf_hi(w.x); u0[2] = bf_lo(w.y); u0[3] = bf_hi(w.y); u0[4] = bf_lo(w.z); u0[5] = bf_hi(w.z); u0[6] = bf_lo(w.w); u0[7] = bf_hi(w.w); }
#pragma unroll
        for (int k = 1; k <= 2; ++k) {
            const int rr = k == 1 ? r1 : r2; float* uu = k == 1 ? u1 : u2;
            if (rr >= 0) { const v4u w = *(const v4u*)(F.PROJ + (size_t)rr * LD_PROJ + e0);
                uu[0] = bf_lo(w.x); uu[1] = bf_hi(w.x); uu[2] = bf_lo(w.y); uu[3] = bf_hi(w.y); uu[4] = bf_lo(w.z); uu[5] = bf_hi(w.z); uu[6] = bf_lo(w.w); uu[7] = bf_hi(w.w); }
            else if (rr == -1) {
#pragma unroll
                for (int j = 0; j < 8; ++j) uu[j] = 0.f; }
            else { const int srow = -2 - rr; const int sb = (row - ROW_S0) >> 3; const float* sp = F.state_conv + (((size_t)lj * DBATCH + sb) * 2 + srow) * DM + e0;
                const f32x4 a = *(const f32x4*)sp, bq = *(const f32x4*)(sp + 4); uu[0] = a.x; uu[1] = a.y; uu[2] = a.z; uu[3] = a.w; uu[4] = bq.x; uu[5] = bq.y; uu[6] = bq.z; uu[7] = bq.w; }
        }
        const v4u gg = *(const v4u*)(pr + DM);
        const float gf[8] = {bf_lo(gg.x), bf_hi(gg.x), bf_lo(gg.y), bf_hi(gg.y), bf_lo(gg.z), bf_hi(gg.z), bf_lo(gg.w), bf_hi(gg.w)};
        float r[8];
#pragma unroll
        for (int j = 0; j < 8; ++j) r[j] = gf[j] * (cw[e0 + j] * u2[j] + cw[DM + e0 + j] * u1[j] + cw[2 * DM + e0 + j] * u0[j]);
        v4u w; w.x = pk2(r[0], r[1]); w.y = pk2(r[2], r[3]); w.z = pk2(r[4], r[5]); w.w = pk2(r[6], r[7]); *o = w;
    }
}

#define IN(k) (lo <= (k) && (k) < hi)
#define OPAQUE(p) asm volatile("" : "+s"(p))
#define FRESH() do { F.lane = (int)__builtin_amdgcn_mbcnt_hi(~0u, __builtin_amdgcn_mbcnt_lo(~0u, 0u)); asm volatile("" : "+v"(F.lane)); F.tid = F.wave * 64 + F.lane; asm volatile("" : "+s"(F.vcu)); } while (0)
#define SEAM(k) do { if (IN((k) + 1)) xcd_barrier(bar); } while (0)
#define SEAM2(k) do { if (IN((k) + 2)) xcd_barrier(bar); } while (0)

#ifndef GEMM_ALIGN
#define GEMM_ALIGN true
#endif
#ifndef GEMM_SP2
#define GEMM_SP2 true
#endif
#ifndef MK_PROBE
#define MK_PROBE 0
#endif
#define PROBE_REP(mask, call) do { if ((MK_PROBE) & (mask)) { xcd_barrier(bar); call; } } while (0)
template <int lj> __device__ __forceinline__ void gemm_ret_in(Frame& F) {
    const bf16* gA = F.XB; const bf16* gB = F.Wri + (size_t)lj * NRI * LD_X; OPAQUE(gA); OPAQUE(gB); pg8::Gemm g{gA, gB, M_PAD, NRI, DM, LD_X}; pg8::StaticOrder S; S.init(M_PAD, NRI, DM, F.G, (int)blockIdx.x);
    EpiRopeBf16 E{F.PROJ, LD_PROJ, F.ROPE, F.QT};
    pg8::gemm_phase<EpiRopeBf16, pg8::StaticOrder, GEMM_ALIGN, GEMM_SP2>(F.lds + RING_OFF, g, S, E, F.wave);
}
template <int lj> __device__ __forceinline__ void gemm_ret_out(Frame& F) {
    const bf16* gA = F.A2; const bf16* gB = F.Wro + (size_t)lj * DM * LD_A2; OPAQUE(gA); OPAQUE(gB); pg8::Gemm g{gA, gB, M_PAD, DM, RV, LD_A2}; pg8::TailOrder S; S.init(ROW_S0, M_PAD, DM, g.K, TAIL_KS, F.G, (int)blockIdx.x);
    EpiResBf16 E{F.HB, F.XB, F.PART, DN_ALPHA};
    pg8::gemm_phase<EpiResBf16, pg8::TailOrder, GEMM_ALIGN, GEMM_SP2>(F.lds + RING_OFF, g, S, E, F.wave);
}
template <int lj> __device__ __forceinline__ void gemm_conv_in(Frame& F) {
    const bf16* gA = F.XB; const bf16* gB = F.Wci + (size_t)lj * NCI * LD_X; OPAQUE(gA); OPAQUE(gB); pg8::Gemm g{gA, gB, M_PAD, NCI, DM, LD_X}; pg8::StaticOrder S; S.init(M_PAD, NCI, DM, F.G, (int)blockIdx.x);
    EpiConvGate E{lj};
    pg8::gemm_phase<EpiConvGate, pg8::StaticOrder, GEMM_ALIGN, GEMM_SP2>(F.lds + RING_OFF, g, S, E, F.wave);
}
template <int lj> __device__ __forceinline__ void gemm_conv_out(Frame& F) {
    const bf16* gA = F.A2; const bf16* gB = F.Wco + (size_t)lj * DM * LD_X; OPAQUE(gA); OPAQUE(gB); pg8::Gemm g{gA, gB, M_PAD, DM, DM, LD_X}; pg8::TailOrder S; S.init(ROW_S0, M_PAD, DM, g.K, TAIL_KS, F.G, (int)blockIdx.x);
    { FRESH(); pg8::Unit fu; for (int i = 0; S.next(i, fu) && pg8::unit_part(fu) < 0; ++i) conv_fixup(F, lj, fu.pm); }
    asm volatile("s_waitcnt vmcnt(0)" ::: "memory"); __syncthreads();
    EpiResBf16 E{F.HB, F.XB, F.PART, DN_ALPHA};
    pg8::gemm_phase<EpiResBf16, pg8::TailOrder, GEMM_ALIGN, GEMM_SP2>(F.lds + RING_OFF, g, S, E, F.wave);
}
struct EpiNull { static constexpr bool PERM = true, AFTER_DRAIN = false; float* sink;
    __device__ __forceinline__ void operator()(const pg8::f32x4 (&acc)[2][2][4][2], const pg8::Unit& u, int wr, int wc, int fr, int fq) const { pg8::f32x4 t = {0.f, 0.f, 0.f, 0.f};
#pragma unroll
        for (int a = 0; a < 2; ++a)
#pragma unroll
            for (int b = 0; b < 2; ++b)
#pragma unroll
                for (int m = 0; m < 4; ++m) { t += acc[a][b][m][0]; t += acc[a][b][m][1]; }
        if (t[0] + t[1] + t[2] + t[3] == 123456.789f) sink[0] = 1.f; } };
template <int lj, int which> __device__ __forceinline__ void gemm_null(Frame& F) {
    const bf16* gA = (which == 0 || which == 2) ? F.XB : F.A2;
    const bf16* gB = which == 0 ? F.Wri + (size_t)lj * NRI * LD_X : which == 1 ? F.Wro + (size_t)lj * DM * LD_A2 : which == 2 ? F.Wci + (size_t)lj * NCI * LD_X : F.Wco + (size_t)lj * DM * LD_X;
    OPAQUE(gA); OPAQUE(gB);
    constexpr int N = which == 0 ? NRI : which == 2 ? NCI : DM, K = which == 1 ? RV : DM, LD = which == 1 ? LD_A2 : LD_X;
    pg8::Gemm g{gA, gB, M_PAD, N, K, LD}; EpiNull E{F.PART};
    if (which == 0 || which == 2) { pg8::StaticOrder S; S.init(M_PAD, N, K, F.G, (int)blockIdx.x); pg8::gemm_phase<EpiNull, pg8::StaticOrder, GEMM_ALIGN, GEMM_SP2>(F.lds + RING_OFF, g, S, E, F.wave); }
    else { pg8::TailOrder S; S.init(ROW_S0, M_PAD, N, K, TAIL_KS, F.G, (int)blockIdx.x); pg8::gemm_phase<EpiNull, pg8::TailOrder, GEMM_ALIGN, GEMM_SP2>(F.lds + RING_OFF, g, S, E, F.wave); }
}
constexpr int N_TAIL_UNITS = (M_PAD - ROW_S0) / 256 * (DM / 256) * TAIL_KS;
template <int lj> __device__ __forceinline__ void layer_pair(Frame& F, const XcdBarrier& bar, const int lo, const int hi) {
    const int pb = 1 + 10 * lj;
    if (IN(pb + 0)) { if ((MK_PROBE) & 512) { gemm_null<lj, 0>(F); xcd_barrier(bar); } gemm_ret_in<lj>(F); PROBE_REP(2, gemm_ret_in<lj>(F)); SEAM(pb + 0); }
    if (IN(pb + 2)) { if ((MK_PROBE) & 64) { FRESH(); retention_phase(F, lj, 8); xcd_barrier(bar); } if ((MK_PROBE) & 128) { FRESH(); retention_phase(F, lj, 16); xcd_barrier(bar); } if ((MK_PROBE) & 256) { FRESH(); retention_phase(F, lj, 32); xcd_barrier(bar); } if ((MK_PROBE) >= 1024) { FRESH(); retention_phase(F, lj, 64 + ((MK_PROBE) >> 10) - 1); xcd_barrier(bar); } FRESH(); retention_phase(F, lj); PROBE_REP(4, FRESH(); retention_phase(F, lj)); PROBE_REP(16, FRESH(); retention_phase(F, lj, 1)); PROBE_REP(32, FRESH(); retention_phase(F, lj, 2)); SEAM(pb + 2); }
    if (IN(pb + 3)) { FRESH(); groupnorm_gate_phase(F); PROBE_REP(8, FRESH(); groupnorm_gate_phase(F)); SEAM(pb + 3); }
    if (IN(pb + 4)) { if ((MK_PROBE) & 512) { gemm_null<lj, 1>(F); xcd_barrier(bar); } gemm_ret_out<lj>(F); if (MK_DEFER_CVT) convert_by_idle<(0x4 << (4 * lj))>(F, N_TAIL_UNITS); PROBE_REP(2, gemm_ret_out<lj>(F)); SEAM(pb + 4); }
    if (IN(pb + 5)) { FRESH(); layernorm_phase(F, 2 * lj, false); SEAM(pb + 5); }
    if (IN(pb + 6)) { if ((MK_PROBE) & 512) { gemm_null<lj, 2>(F); xcd_barrier(bar); } gemm_conv_in<lj>(F); if (MK_DEFER_CVT) convert_by_idle<(lj == 0 ? 0x18 : 0x80)>(F, (M_PAD / 256) * (NCI / 256) % 256); PROBE_REP(2, gemm_conv_in<lj>(F)); SEAM(pb + 6); }
    if (IN(pb + 8)) { if ((MK_PROBE) & 512) { gemm_null<lj, 3>(F); xcd_barrier(bar); } gemm_conv_out<lj>(F); if (MK_DEFER_CVT) convert_by_idle<(lj == 0 ? 0x20 : 0)>(F, N_TAIL_UNITS); PROBE_REP(2, gemm_conv_out<lj>(F)); SEAM(pb + 8); }
    if (IN(pb + 9)) { FRESH(); layernorm_phase(F, 2 * lj + 1, lj == 1); SEAM(pb + 9); }
}

constexpr int NPHASE = 21;
__global__ void __launch_bounds__(NWAVES * 64, 2) mk_fwd(Args args) {
    extern __shared__ __attribute__((aligned(16))) unsigned char lds[];
    Frame F;
    F.lds = (LAS unsigned char*)lds;
    F.MISC = (volatile LAS unsigned*)(F.lds + MISC_OFF);
    F.tid = threadIdx.x; F.lane = F.tid & 63; F.wave = __builtin_amdgcn_readfirstlane(F.tid >> 6);
    F.G = gridDim.x; { const int bx = blockIdx.x; F.vcu = (F.G % 8 == 0) ? (bx % 8) * (F.G / 8) + bx / 8 : bx; }
    unsigned char* ws = args.ws;
    F.ctl = (gu32*)(ws + WS_CTL);
    F.x_prompt = args.in[0]; F.x_sample = args.in[1]; F.state_ret = args.in[2]; F.state_conv = args.in[3]; F.meta = args.in[4]; F.w_ret_in = args.in[5];
    F.w_ret_out = args.in[6]; F.w_conv_in = args.in[7]; F.conv_w = args.in[8]; F.w_conv_out = args.in[9]; F.ln_g = args.in[10]; F.ln_b = args.in[11];
    F.out = args.out;
    F.Wri = (bf16*)(ws + WS_WRI); F.Wro = (bf16*)(ws + WS_WRO); F.Wci = (bf16*)(ws + WS_WCI); F.Wco = (bf16*)(ws + WS_WCO);
    F.XB = (bf16*)(ws + WS_XB); F.PROJ = (bf16*)(ws + WS_PROJ); F.A2 = (bf16*)(ws + WS_A2);
    F.HB = (bf16*)(ws + WS_H); F.QT = (bf16*)(ws + WS_XF); F.PART = (float*)(ws + WS_PART); F.YF = (float*)(ws + WS_YF); F.YB = (bf16*)(ws + WS_YF); F.ROPE = (float*)(ws + WS_ROPE);
    for (int u = F.tid; u < (LDS_BYTES - LDSCTL_OFF) / 4; u += NWAVES * 64) ((LAS unsigned*)(F.lds + LDSCTL_OFF))[u] = 0u;
    __syncthreads();
    XcdBarrier bar; bar.bar = (unsigned*)(F.ctl + CW_BAR); bar.x = 0; bar.st = nullptr;
    if (MK_N_LAUNCHES == 1) bar = xcd_barrier_post((unsigned*)(F.ctl + CW_BAR), F.MISC + 8);
    const int lo = args.ph_lo, hi = args.ph_hi;
    if (IN(0)) { FRESH(); p0_prologue(F, args.freq); PROBE_REP(1, FRESH(); p0_prologue(F, args.freq)); SEAM(0); }
    layer_pair<0>(F, bar, lo, hi);
    layer_pair<1>(F, bar, lo, hi);
#undef IN
#undef SEAM
}

extern "C" void kernel_launch(void* const* d_in, const int* in_sizes, int n_in, void* d_out, int out_size, void* d_ws, size_t ws_size, hipStream_t stream) {
    static int grid = 0;
    if (grid == 0) {
        if (n_in != 12 || (size_t)out_size != O_END || ws_size < WS_END) { fprintf(stderr, "kernel_launch: unexpected shapes: n_in %d out %d ws %zu (need %zu)\n", n_in, out_size, ws_size, (size_t)WS_END); grid = -1; return; }
        int dev = 0, cus = 0, per_cu = 0;
        if (hipGetDevice(&dev) != hipSuccess || hipDeviceGetAttribute(&cus, hipDeviceAttributeMultiprocessorCount, dev) != hipSuccess) { grid = -1; return; }
        if (hipFuncSetAttribute((const void*)mk_fwd, hipFuncAttributeMaxDynamicSharedMemorySize, LDS_BYTES) != hipSuccess) { fprintf(stderr, "kernel_launch: hipFuncSetAttribute failed\n"); grid = -1; return; }
        if (hipOccupancyMaxActiveBlocksPerMultiprocessor(&per_cu, (const void*)mk_fwd, NWAVES * 64, LDS_BYTES) != hipSuccess || per_cu < 1) { fprintf(stderr, "kernel_launch: occupancy query says %d blocks per CU\n", per_cu); }
        (void)hipGetLastError();
        grid = cus;
    }
    if (grid < 0) return;
    if (hipMemsetAsync((char*)d_ws + WS_CTL, 0, CTL_ZERO_BYTES, stream) != hipSuccess) { fprintf(stderr, "kernel_launch: memset failed\n"); return; }
    Args a{};
    for (int i = 0; i < 12; ++i) a.in[i] = (const float*)d_in[i];
    a.out = (float*)d_out; a.ws = (unsigned char*)d_ws;
    for (int d = 0; d < 128; ++d) a.freq[d] = (float)pow(10000.0, -(double)d / 128.0);
#if MK_N_LAUNCHES == 1
    a.ph_lo = 0; a.ph_hi = NPHASE;
    hipLaunchKernelGGL(mk_fwd, dim3(grid), dim3(NWAVES * 64), LDS_BYTES, stream, a);
#else
    for (int p = 0; p < NPHASE; ++p) { a.ph_lo = p; a.ph_hi = p + 1; hipLaunchKernelGGL(mk_fwd, dim3(grid), dim3(NWAVES * 64), LDS_BYTES, stream, a); }
#endif
    const hipError_t le = hipPeekAtLastError();
    if (le != hipSuccess) fprintf(stderr, "kernel_launch: launch failed: %s\n", hipGetErrorName(le));
}
```

```cpp
#include <hip/hip_runtime.h>
#include <cstdio>
#include <cstdint>
#include <cmath>
namespace pg8 {
#define PG8_LAS __attribute__((address_space(3)))
typedef unsigned short bf16_t;
typedef short bf16x8 __attribute__((ext_vector_type(8)));
typedef float f32x4 __attribute__((ext_vector_type(4)));
typedef unsigned u32x4 __attribute__((ext_vector_type(4)));
constexpr int BM = 256, BK = 64, HALF = 128, HTB = HALF * BK * 2  , STAGE_BYTES = 8 * HTB, NXCD = 8, WGM = 8;

__host__ __device__ __forceinline__ int lds_byte(int r, int c) { const int st = (r >> 4) * 2 + (c >> 5), rr = r & 15, cc = c & 31, ob = rr * 64 + cc * 2; return st * 1024 + (ob ^ (((ob >> 9) & 1) << 5)); }
__host__ __device__ __forceinline__ void stage_rc(int b, int& R, int& C) { const int st = b / 1024, sb = b % 1024, swz = sb ^ (((sb >> 9) & 1) << 5); R = (st >> 1) * 16 + swz / 64; C = (st & 1) * 32 + (swz % 64) / 2; }
__host__ __device__ __forceinline__ int perm32(int rho) { const int n = rho >> 4, i = rho & 15; return 8 * (i >> 2) + 4 * n + (i & 3); }

struct Unit { int pm, pn; };
__host__ __device__ __forceinline__ int unit_pn(const Unit& u) { return u.pn & 255; }
__host__ __device__ __forceinline__ int unit_part(const Unit& u) { return (u.pn >> 8) - 1; }
struct Gemm { const bf16_t* A; const bf16_t* Bt; int M, N, K, ld; };

struct StaticOrder {
    int nM, nN, nwg, G, c, ntf;
    __host__ __device__ __forceinline__ void init(int M, int N, int K, int G_, int c_) { nM = M / BM; nN = N / BM; nwg = nM * nN; G = G_; c = c_; ntf = K / BK; }
    __host__ __device__ __forceinline__ bool next(int i, Unit& u) const {
        const long L = (long)i * G + c; if (L >= nwg) return false;
        int wgid = (int)L; { const int q = nwg / NXCD, r = nwg % NXCD, xcd = wgid % NXCD, off = wgid / NXCD; wgid = (xcd < r ? xcd * (q + 1) : r * (q + 1) + (xcd - r) * q) + off; }
        const int nig = WGM * nN, gid = wgid / nig, fm = gid * WGM, gsz = (nM - fm) < WGM ? (nM - fm) : WGM;
        u.pm = fm + ((wgid % nig) % gsz); u.pn = (wgid % nig) / gsz; return true;
    }
    __device__ __forceinline__ void a_ready(const Unit&) const {}
    __device__ __forceinline__ void done(const Unit&) const {}
    __device__ __forceinline__ int nt_of(const Unit&) const { return ntf; }
    __device__ __forceinline__ int k0_of(const Unit&) const { return 0; }
};
struct TailOrder {
    StaticOrder full; int nMf, nMt, nN, G, c, KS, ntp, nfull;
    __host__ __device__ __forceinline__ void init(int Mfull, int M, int N, int K, int KS_, int G_, int c_) { full.init(Mfull, N, K, G_, c_); nMf = Mfull / BM; nMt = M / BM - nMf; nN = N / BM; G = G_; c = c_; KS = KS_; ntp = K / BK / KS_; nfull = nMf * nN; }
    __host__ __device__ __forceinline__ bool next(int i, Unit& u) const {
        const long L = (long)i * G + c;
        if (L < nfull) return full.next(i, u);
        const int j = (int)(L - nfull); if (j >= nMt * nN * KS) return false;
        const int tile = j / KS; u.pm = nMf + tile % nMt; u.pn = tile / nMt + 256 * (1 + j % KS); return true;
    }
    __device__ __forceinline__ void a_ready(const Unit&) const {}
    __device__ __forceinline__ void done(const Unit&) const {}
    __device__ __forceinline__ int nt_of(const Unit& u) const { return (u.pn >> 8) ? ntp : full.ntf; }
    __device__ __forceinline__ int k0_of(const Unit& u) const { const int p = u.pn >> 8; return p ? (p - 1) * ntp * BK : 0; }
};


__device__ __forceinline__ unsigned cvt_pk_bf16(float lo, float hi) { unsigned r; asm volatile("v_cvt_pk_bf16_f32 %0, %1, %2" : "=v"(r) : "v"(lo), "v"(hi)); return r; }
typedef float f32x2 __attribute__((ext_vector_type(2)));
__device__ __forceinline__ f32x2 gelu_pk(f32x2 v) {
    const f32x2 av = __builtin_elementwise_abs(v), d = av * 0.2316418882f + 1.0f;
    f32x2 t; t.x = __builtin_amdgcn_rcpf(d.x); t.y = __builtin_amdgcn_rcpf(d.y);
    f32x2 q = t * 0.5307027145f + (-0.7265760135f); q = q * t + 0.7107068705f; q = q * t + (-0.142248368f); q = q * t + 0.127414796f; q = q * t;
    const f32x2 s = (v * v) * (-0.72134752044f);
    f32x2 e; e.x = __builtin_amdgcn_exp2f(s.x); e.y = __builtin_amdgcn_exp2f(s.y);
    const f32x2 m = v * (q * e), r = v - m;
    f32x2 o; o.x = v.x < 0.f ? m.x : r.x; o.y = v.y < 0.f ? m.y : r.y; return o;
}

template <int ACT  > struct EpiBf16 {
    static constexpr bool PERM = true, AFTER_DRAIN = false; static_assert(ACT == 0 || ACT == 1, "EpiBf16: ACT is 0 (none) or 1 (gelu_pk)");
    bf16_t* O; int ldc; const float* bias; int split_cols; size_t split_stride; float scale0;
    __device__ __forceinline__ void operator()(const f32x4 (&acc)[2][2][4][2], const Unit& u, int wr, int wc, int fr, int fq) const {
        const int row0 = u.pm * BM + wr * 64 + fr; int colt = u.pn * BM; bf16_t* base = O;
        float sc = 1.f; if (split_cols) { const int t = colt / split_cols; base += (size_t)t * split_stride; colt -= t * split_cols; if (t == 0) sc = scale0; }
        const int col0 = colt + wc * 32 + 8 * fq, bcol0 = u.pn * BM + wc * 32 + 8 * fq;
        f32x4 bv[2][2];
#pragma unroll
        for (int bj = 0; bj < 2; ++bj)
#pragma unroll
            for (int n = 0; n < 2; ++n) bv[bj][n] = bias ? *(const f32x4*)(bias + bcol0 + bj * HALF + 4 * n) : (f32x4){0.f, 0.f, 0.f, 0.f};
#pragma unroll
        for (int ai = 0; ai < 2; ++ai)
#pragma unroll
            for (int m = 0; m < 4; ++m) { bf16_t* rowp = base + (size_t)(row0 + ai * HALF + m * 16) * ldc + col0;
#pragma unroll
                for (int bj = 0; bj < 2; ++bj) { f32x4 v0 = acc[ai][bj][m][0] + bv[bj][0], v1 = acc[ai][bj][m][1] + bv[bj][1];
                    if (ACT == 1) { f32x2 a = gelu_pk((f32x2){v0[0], v0[1]}), b = gelu_pk((f32x2){v0[2], v0[3]}), c = gelu_pk((f32x2){v1[0], v1[1]}), d = gelu_pk((f32x2){v1[2], v1[3]});
                        v0 = (f32x4){a.x, a.y, b.x, b.y}; v1 = (f32x4){c.x, c.y, d.x, d.y}; }
                    v0 = v0 * sc; v1 = v1 * sc; u32x4 w; w.x = cvt_pk_bf16(v0[0], v0[1]); w.y = cvt_pk_bf16(v0[2], v0[3]); w.z = cvt_pk_bf16(v1[0], v1[1]); w.w = cvt_pk_bf16(v1[2], v1[3]);
                    *(u32x4*)(rowp + bj * HALF) = w; } }
    }
};

template <class Epi, class Sched, bool ALIGN_EPI = false, bool SP2 = false>
__device__ __forceinline__ void gemm_phase(PG8_LAS unsigned char* lds, const Gemm g, const Sched& S, const Epi& E, const int wave_idx) {
    int tid_ = (int)__builtin_amdgcn_mbcnt_hi(~0u, __builtin_amdgcn_mbcnt_lo(~0u, 0u)); asm volatile("" : "+v"(tid_)); tid_ += 64 * wave_idx;
    const int tid = tid_, wid = __builtin_amdgcn_readfirstlane(tid >> 6), lane = tid & 63, wr = wid >> 2, wc = wid & 3, fr = lane & 15, fq = lane >> 4;
    const int K = g.K;
    unsigned voffA[2], voffB[2];
#pragma unroll
    for (int i = 0; i < 2; ++i) { int R, C; stage_rc(tid * 16 + i * 8192, R, C); const int Rb = Epi::PERM ? ((R & ~31) + perm32(R & 31)) : R;
        voffA[i] = (unsigned)(R * g.ld + C) * 2u; voffB[i] = (unsigned)(Rb * g.ld + C) * 2u; }
    const size_t kstep = (size_t)(BK * 2);
    const size_t hstep = (size_t)HALF * g.ld * 2;
    const size_t tstep = 2 * hstep;
    const unsigned ldsw = (unsigned)wid * 1024u;
    const int aoff = lds_byte(wr * 64 + fr, fq * 8), boff = lds_byte(wc * 32 + fr, fq * 8);
#define PG8_SA(b, h) (((b) * 2 + (h)) * HTB)
#define PG8_SB(b, h) ((4 + (b) * 2 + (h)) * HTB)
#define PG8_STAGE(bufoff, gbase, voff) do { _Pragma("unroll") for (int _i = 0; _i < 2; ++_i) \
        __builtin_amdgcn_global_load_lds((const unsigned*)((const char*)(gbase) + (voff)[_i]), (PG8_LAS unsigned*)(lds + (bufoff) + ldsw + _i * 8192), 16, 0, 0); } while (0)
#define PG8_LDA(dst, b, h) do { _Pragma("unroll") for (int m = 0; m < 4; ++m) _Pragma("unroll") for (int k = 0; k < 2; ++k) dst[m][k] = *(const PG8_LAS bf16x8*)(lds + PG8_SA(b, h) + aoff + m * 2048 + k * 1024); } while (0)
#define PG8_LDB(dst, b, h) do { _Pragma("unroll") for (int n = 0; n < 2; ++n) _Pragma("unroll") for (int k = 0; k < 2; ++k) dst[n][k] = *(const PG8_LAS bf16x8*)(lds + PG8_SB(b, h) + boff + n * 2048 + k * 1024); } while (0)
#define PG8_MMA(ai, bj, At, Bt) do { __builtin_amdgcn_s_setprio(1); _Pragma("unroll") for (int m = 0; m < 4; ++m) _Pragma("unroll") for (int n = 0; n < 2; ++n) _Pragma("unroll") for (int k = 0; k < 2; ++k) \
        acc[ai][bj][m][n] = __builtin_amdgcn_mfma_f32_16x16x32_bf16(Bt[n][k], At[m][k], acc[ai][bj][m][n], 0, 0, 0); __builtin_amdgcn_s_setprio(0); } while (0)
#define PG8_WAIT_V(n) asm volatile("s_waitcnt vmcnt(" #n ")" ::: "memory")
#define PG8_WAIT_L(n) asm volatile("s_waitcnt lgkmcnt(" #n ")" ::: "memory")
#define PG8_BAR __builtin_amdgcn_s_barrier()
#define PG8_SCHED __builtin_amdgcn_sched_barrier(0)
    Unit cur, nxt; int ui = 0;
    if (!S.next(0, cur)) return;
    f32x4 acc[2][2][4][2];
#pragma unroll
    for (int a = 0; a < 2; ++a)
#pragma unroll
        for (int b = 0; b < 2; ++b)
#pragma unroll
            for (int m = 0; m < 4; ++m)
#pragma unroll
                for (int n = 0; n < 2; ++n) acc[a][b][m][n] = (f32x4){0.f, 0.f, 0.f, 0.f};
    bf16x8 At[4][2], B0[2][2], B1[2][2];
    const char* cA = (const char*)g.A + (size_t)cur.pm * tstep + (size_t)S.k0_of(cur) * 2; const char* cB = (const char*)g.Bt + (size_t)unit_pn(cur) * tstep + (size_t)S.k0_of(cur) * 2;
    int nt = S.nt_of(cur);
    S.a_ready(cur);
    if constexpr (SP2) {
        PG8_STAGE(PG8_SB(0, 0), cB, voffB); PG8_STAGE(PG8_SB(0, 1), cB + hstep, voffB); PG8_STAGE(PG8_SA(0, 0), cA, voffA); PG8_STAGE(PG8_SA(0, 1), cA + hstep, voffA);
        if (wr == 1) PG8_BAR;
        PG8_WAIT_V(2); PG8_BAR;
        PG8_STAGE(PG8_SB(1, 0), cB + kstep, voffB); PG8_STAGE(PG8_SA(1, 0), cA + kstep, voffA); PG8_STAGE(PG8_SB(1, 1), cB + hstep + kstep, voffB);
        PG8_WAIT_V(6); PG8_BAR;
    } else {
        PG8_STAGE(PG8_SB(0, 0), cB, voffB); PG8_STAGE(PG8_SA(0, 0), cA, voffA); PG8_STAGE(PG8_SB(0, 1), cB + hstep, voffB); PG8_STAGE(PG8_SA(0, 1), cA + hstep, voffA);
        if (wr == 1) PG8_BAR;
        PG8_WAIT_V(4); PG8_BAR;
        PG8_STAGE(PG8_SB(1, 0), cB + kstep, voffB); PG8_STAGE(PG8_SA(1, 0), cA + kstep, voffA); PG8_STAGE(PG8_SB(1, 1), cB + hstep + kstep, voffB);
        PG8_WAIT_V(6); PG8_BAR;
    }
    for (;;) {
        const bool has_next = S.next(ui + 1, nxt);
        const char* nA = has_next ? (const char*)g.A + (size_t)nxt.pm * tstep + (size_t)S.k0_of(nxt) * 2 : cA; const char* nB = has_next ? (const char*)g.Bt + (size_t)unit_pn(nxt) * tstep + (size_t)S.k0_of(nxt) * 2 : cB;
        for (int t = 0; t < nt; t += 2) {
            const bool last = (t == nt - 2);
            const char* a1 = cA + (size_t)(t + 1) * kstep;
            const char* a2 = last ? nA : cA + (size_t)(t + 2) * kstep; const char* b2 = last ? nB : cB + (size_t)(t + 2) * kstep;
            const char* a3 = a2 + kstep; const char* b3 = b2 + kstep;
            if (last && has_next) S.a_ready(nxt);
            if constexpr (SP2) {
            PG8_LDB(B0, 0, 0); PG8_LDB(B1, 0, 1); PG8_SCHED; PG8_LDA(At, 0, 0); PG8_STAGE(PG8_SA(1, 1), a1 + hstep, voffA);
            PG8_WAIT_V(8); PG8_WAIT_L(0); PG8_BAR; PG8_MMA(0, 0, At, B0); PG8_MMA(0, 1, At, B1); PG8_BAR; PG8_SCHED;
            PG8_LDA(At, 0, 1); PG8_STAGE(PG8_SB(0, 0), b2, voffB); PG8_STAGE(PG8_SB(0, 1), b2 + hstep, voffB); PG8_STAGE(PG8_SA(0, 0), a2, voffA);
            PG8_WAIT_V(8); PG8_WAIT_L(0); PG8_BAR; PG8_MMA(1, 0, At, B0); PG8_MMA(1, 1, At, B1); PG8_BAR; PG8_SCHED;
            PG8_LDB(B0, 1, 0); PG8_LDB(B1, 1, 1); PG8_SCHED; PG8_LDA(At, 1, 0); PG8_STAGE(PG8_SA(0, 1), a2 + hstep, voffA);
            PG8_WAIT_V(8); PG8_WAIT_L(0); PG8_BAR; PG8_MMA(0, 0, At, B0); PG8_MMA(0, 1, At, B1); PG8_BAR; PG8_SCHED;
            PG8_LDA(At, 1, 1); PG8_STAGE(PG8_SB(1, 0), b3, voffB); PG8_STAGE(PG8_SB(1, 1), b3 + hstep, voffB); PG8_STAGE(PG8_SA(1, 0), a3, voffA);
            PG8_WAIT_V(8); PG8_WAIT_L(0); PG8_BAR; PG8_MMA(1, 0, At, B0); PG8_MMA(1, 1, At, B1); PG8_BAR; PG8_SCHED;
            } else {
            PG8_LDB(B0, 0, 0); PG8_SCHED; PG8_LDA(At, 0, 0); PG8_STAGE(PG8_SA(1, 1), a1 + hstep, voffA);
            PG8_WAIT_L(8); PG8_BAR; PG8_WAIT_L(0); PG8_MMA(0, 0, At, B0); PG8_BAR; PG8_SCHED;
            PG8_LDB(B1, 0, 1); PG8_STAGE(PG8_SB(0, 0), b2, voffB);
            PG8_BAR; PG8_WAIT_L(0); PG8_MMA(0, 1, At, B1); PG8_BAR;
            PG8_LDA(At, 0, 1); PG8_STAGE(PG8_SA(0, 0), a2, voffA);
            PG8_BAR; PG8_WAIT_L(0); PG8_MMA(1, 0, At, B0); PG8_BAR; PG8_SCHED;
            PG8_STAGE(PG8_SB(0, 1), b2 + hstep, voffB);
            PG8_WAIT_V(6); PG8_BAR; PG8_MMA(1, 1, At, B1); PG8_BAR;
            PG8_LDB(B0, 1, 0); PG8_SCHED; PG8_LDA(At, 1, 0); PG8_STAGE(PG8_SA(0, 1), a2 + hstep, voffA);
            PG8_WAIT_L(8); PG8_BAR; PG8_WAIT_L(0); PG8_MMA(0, 0, At, B0); PG8_BAR; PG8_SCHED;
            PG8_LDB(B1, 1, 1); PG8_STAGE(PG8_SB(1, 0), b3, voffB);
            PG8_BAR; PG8_WAIT_L(0); PG8_MMA(0, 1, At, B1); PG8_BAR;
            PG8_LDA(At, 1, 1); PG8_STAGE(PG8_SA(1, 0), a3, voffA);
            PG8_BAR; PG8_WAIT_L(0); PG8_MMA(1, 0, At, B0); PG8_BAR; PG8_SCHED;
            PG8_STAGE(PG8_SB(1, 1), b3 + hstep, voffB);
            PG8_WAIT_V(6); PG8_BAR; PG8_MMA(1, 1, At, B1); PG8_BAR;
            }
        }
        if constexpr (ALIGN_EPI) { if (wr == 0) PG8_BAR; }
        if constexpr (!Epi::AFTER_DRAIN) { E(acc, cur, wr, wc, fr, fq); S.done(cur); }
        if (!has_next) break;
#pragma unroll
        for (int a = 0; a < 2; ++a)
#pragma unroll
            for (int b = 0; b < 2; ++b)
#pragma unroll
                for (int m = 0; m < 4; ++m)
#pragma unroll
                    for (int n = 0; n < 2; ++n) acc[a][b][m][n] = (f32x4){0.f, 0.f, 0.f, 0.f};
        cur = nxt; cA = nA; cB = nB; ++ui; nt = S.nt_of(cur);
        if constexpr (ALIGN_EPI) { if (wr == 1) PG8_BAR; }
    }
    PG8_WAIT_V(0);
    if constexpr (!ALIGN_EPI) { if (wr == 0) PG8_BAR; }
    PG8_BAR;
    if constexpr (Epi::AFTER_DRAIN) { E.fused(acc, cur, wr, wc, fr, fq, lds, wid, lane); S.done(cur); }
#undef PG8_SA
#undef PG8_SB
#undef PG8_STAGE
#undef PG8_LDA
#undef PG8_LDB
#undef PG8_MMA
#undef PG8_WAIT_V
#undef PG8_WAIT_L
#undef PG8_BAR
#undef PG8_SCHED
}
}

#ifndef MK_N_LAUNCHES
#define MK_N_LAUNCHES 1
#endif
constexpr int NWAVES = 8;

constexpr int DM = 2048, NBATCH = 4, SEQ = 2048, NMETA = 16, DBATCH = 128, DSEQ = 8, PAST = 16384;
constexpr int NH = 8, DK = 256, DV = 512, RQK = 2048, RV = 4096, NRI = 2 * RQK + 2 * RV  , NCI = 4 * DM  ;
constexpr int ROW_S0 = NBATCH * SEQ  , ROW_M0 = ROW_S0 + DBATCH * DSEQ  , M_REAL = ROW_M0 + NMETA  , M_PAD = 9472  ;
constexpr int NPOS = NMETA + SEQ + DSEQ;
constexpr float LN_EPS = 1e-5f, GN_EPS = 1e-6f;
constexpr int LDP = 64, LD_X = DM + LDP  , LD_A2 = RV + LDP  , LD_PROJ = NRI + LDP  , LD_Y = RV + LDP  ;
constexpr float DN_ALPHA = 1.681792830507429f;
constexpr size_t O_YP = 0, O_YS = O_YP + (size_t)NBATCH * SEQ * DM, O_SRP = O_YS + (size_t)DBATCH * DSEQ * DM, O_SRS = O_SRP + (size_t)2 * NBATCH * NH * DK * DV,
                 O_SCP = O_SRS + (size_t)2 * DBATCH * NH * DK * DV, O_SCS = O_SCP + (size_t)2 * NBATCH * 2 * DM, O_END = O_SCS + (size_t)2 * DBATCH * 2 * DM;

constexpr size_t MiB = 1u << 20;
constexpr size_t WS_CTL = 0, CTL_ZERO_BYTES = 64 * 1024;
constexpr size_t WS_WRI = 2 * MiB;
constexpr size_t WS_WRO = WS_WRI + (size_t)2 * NRI * LD_X * 2;
constexpr size_t WS_WCI = WS_WRO + (size_t)2 * DM * LD_A2 * 2;
constexpr size_t WS_WCO = WS_WCI + (size_t)2 * NCI * LD_X * 2;
constexpr size_t WS_ROPE = WS_WCO + (size_t)2 * DM * LD_X * 2;
constexpr size_t WS_XF = WS_ROPE + 4 * MiB;
constexpr size_t WS_XB = WS_XF + (size_t)M_PAD * DM * 4;
constexpr size_t WS_PROJ = WS_XB + (size_t)M_PAD * LD_X * 2;
constexpr size_t WS_A2 = WS_PROJ + (size_t)M_PAD * LD_PROJ * 2;
constexpr size_t WS_H = WS_A2 + (size_t)M_PAD * LD_A2 * 2;
constexpr size_t WS_YF = WS_H + (size_t)M_PAD * DM * 4;
constexpr size_t WS_PART = WS_YF + (size_t)M_PAD * RV * 4;
constexpr int TAIL_KS = 4;
#ifndef MK_DEFER_CVT
#define MK_DEFER_CVT 1
#endif
constexpr int W_ALL = 0xFF, W_IN_PROLOGUE = MK_DEFER_CVT ? 0x03 : W_ALL;
constexpr size_t WS_END = WS_PART + (size_t)TAIL_KS * (M_PAD - ROW_S0) * DM * 4;
constexpr int CW_QUEUE = 1024;
constexpr int CW_BAR = 4096;

constexpr int RING_OFF = 0, RING_BYTES = 139264;
constexpr int LDSCTL_OFF = RING_BYTES, MISC_OFF = LDSCTL_OFF + 320;
constexpr int LDS_BYTES = 147456;

#define GAS __attribute__((address_space(1)))
#define LAS __attribute__((address_space(3)))
typedef unsigned short bf16;
typedef unsigned v4u __attribute__((ext_vector_type(4)));
typedef unsigned v2u __attribute__((ext_vector_type(2)));
typedef float f32x4 __attribute__((ext_vector_type(4)));
typedef GAS unsigned gu32;
#define RLX_AGENT __ATOMIC_RELAXED, __HIP_MEMORY_SCOPE_AGENT
#define LDS_WAIT() asm volatile("s_waitcnt lgkmcnt(0)" ::: "memory")
#define VM_WAIT() asm volatile("s_waitcnt vmcnt(0)" ::: "memory")
__device__ __forceinline__ unsigned f2bf(float f) { unsigned u = __builtin_bit_cast(unsigned, f); return (u + 0x7fffu + ((u >> 16) & 1u)) >> 16; }
__device__ __forceinline__ unsigned pk2(float lo, float hi) { return f2bf(lo) | (f2bf(hi) << 16); }
__device__ __forceinline__ float bf_lo(unsigned w) { return __builtin_bit_cast(float, w << 16); }
__device__ __forceinline__ float bf_hi(unsigned w) { return __builtin_bit_cast(float, w & 0xffff0000u); }
__device__ __forceinline__ float bf2f(bf16 b) { return __builtin_bit_cast(float, ((unsigned)b) << 16); }

#define XB_TMO      128
#define XB_XCNT(j)  (256  + 64 * (j))
#define XB_XSUB(j)  (1280 + 64 * (j))
#define XB_XGEN(j)  (2304 + 64 * (j))
#define XB_TOP      3328
#define XB_TOPGEN   3392
#define XCD_BAR_WORDS 3456
#define XB_SPIN_CAP (1u << 20)

__device__ __forceinline__ unsigned xb_ld(unsigned* p)              { return __hip_atomic_load(p, __ATOMIC_RELAXED, __HIP_MEMORY_SCOPE_AGENT); }
__device__ __forceinline__ unsigned xb_add(unsigned* p, unsigned v) { return __hip_atomic_fetch_add(p, v, __ATOMIC_RELAXED, __HIP_MEMORY_SCOPE_AGENT); }
__device__ __forceinline__ unsigned xb_xcc_id() { return (unsigned)__builtin_amdgcn_s_getreg((3 << 11) | 20) & 0xFu; }
#define XB_SPIN(cond, bar) do { unsigned _sp = 0; while (cond) { __builtin_amdgcn_s_sleep(1); \
    if ((++_sp & 255u) == 0u) { if (xb_ld(&(bar)[XB_TMO])) break; if (_sp > XB_SPIN_CAP) { atomicAdd(&(bar)[XB_TMO], 1u); break; } } } } while (0)

struct XcdBarrier { unsigned* bar; unsigned x; volatile LAS unsigned* st; };

__device__ __forceinline__ XcdBarrier xcd_barrier_post(unsigned* bar, volatile LAS unsigned* st) {
    XcdBarrier b; b.bar = bar; b.x = xb_xcc_id(); b.st = st;
    if (threadIdx.x == 0) (void)xb_add(&bar[XB_XCNT(b.x)], 1u);
    return b;
}
__device__ __forceinline__ void xcd_barrier_complete(unsigned* bar, unsigned x, unsigned& nloc, unsigned& nx) {
    const unsigned G = gridDim.x * gridDim.y * gridDim.z;
    unsigned sum, cnt, mine, sp = 0u;
    for (;;) {
        sum = 0u; cnt = 0u; mine = 0u;
#pragma unroll
        for (unsigned j = 0; j < 16; ++j) { const unsigned c = xb_ld(&bar[XB_XCNT(j)]); sum += c; cnt += (c > 0u) ? 1u : 0u; mine = (j == x) ? c : mine; }
        if (sum == G) break;
        __builtin_amdgcn_s_sleep(1);
        if ((++sp & 255u) == 0u) { if (xb_ld(&bar[XB_TMO])) break; if (sp > XB_SPIN_CAP) { atomicAdd(&bar[XB_TMO], 1u); break; } }
    }
    nloc = mine > 0u ? mine : 1u; nx = cnt > 0u ? cnt : 1u;
}
__device__ __forceinline__ void xcd_barrier(const XcdBarrier& b) {
    asm volatile("s_waitcnt vmcnt(0)" ::: "memory");
    __syncthreads();
    if (threadIdx.x == 0) {
        unsigned* bar = b.bar;
        __builtin_amdgcn_s_waitcnt(0);
        unsigned nloc = b.st[0], nx = b.st[1];
        if (nloc == 0u) { xcd_barrier_complete(bar, b.x, nloc, nx); b.st[0] = nloc; b.st[1] = nx; }
        const unsigned old = xb_add(&bar[XB_XSUB(b.x)], 1u);
        const unsigned gen = old / nloc;
        const unsigned ep = b.st[2];
        if (old + 1u == (gen + 1u) * nloc) {
            __builtin_amdgcn_fence(__ATOMIC_RELEASE, "agent");
            asm volatile("s_waitcnt vmcnt(0)" ::: "memory");
            const unsigned og = xb_add(&bar[XB_TOP], 1u);
            const unsigned tg = og / nx;
            if (og + 1u == (tg + 1u) * nx) xb_add(&bar[XB_TOPGEN], 1u);
            else XB_SPIN(xb_ld(&bar[XB_TOPGEN]) == tg, bar);
            __builtin_amdgcn_fence(__ATOMIC_ACQUIRE, "agent");
            asm volatile("s_waitcnt vmcnt(0)" ::: "memory");
        } else {
            XB_SPIN(xb_ld(&bar[XB_TOPGEN]) == ep, bar);
            __builtin_amdgcn_fence(__ATOMIC_ACQUIRE, "agent");
            asm volatile("s_waitcnt vmcnt(0)" ::: "memory");
        }
        b.st[2] = ep + 1u;
    }
    __syncthreads();
}

struct Frame {
    LAS unsigned char* lds;
    volatile LAS unsigned* MISC;
    gu32* ctl;
    int tid, lane, wave, vcu, G;
    const float *x_prompt, *x_sample, *state_ret, *state_conv, *meta, *w_ret_in, *w_ret_out, *w_conv_in, *conv_w, *w_conv_out, *ln_g, *ln_b;
    float* out;
    bf16 *Wri, *Wro, *Wci, *Wco, *XB, *PROJ, *A2;
    float *YF, *ROPE, *PART; bf16 *YB, *HB, *QT;
};
__device__ __forceinline__ float wave_sum(float v) {
#pragma unroll
    for (int o = 1; o < 64; o <<= 1) v += __shfl_xor(v, o);
    return v;
}
__device__ __forceinline__ int row_pos_idx(int row) { return row < ROW_S0 ? (row & (SEQ - 1)) + NMETA : (row < ROW_M0 ? NMETA + SEQ + ((row - ROW_S0) & (DSEQ - 1)) : (row < M_REAL ? row - ROW_M0 : 0)); }

__host__ __device__ __forceinline__ int conv_col_perm(int n) { const int g = n >> 11, e = n & 2047, pn = e >> 6, el = e & 63; return 256 * pn + 128 * (g >> 1) + 32 * (el >> 4) + 8 * ((el >> 2) & 3) + 4 * (g & 1) + (el & 3); }
template <bool CPERM = false> __device__ __forceinline__ void p0_transpose_item(const float* W, int K, int N, bf16* WT, int ldw, LAS float* scr, int item, int lane) {
    const int nblk = N / 32, kb = item / nblk, nb = item % nblk, k0 = 64 * kb, n0 = 32 * nb;
#pragma unroll 8
    for (int i = 0; i < 32; ++i) { const int kk = 2 * i + (lane >> 5); scr[kk * 33 + (lane & 31)] = W[(size_t)(k0 + kk) * N + n0 + (lane & 31)]; }
    LDS_WAIT(); asm volatile("" ::: "memory");
    const int c = lane & 7;
#pragma unroll
    for (int j = 0; j < 4; ++j) { const int n = (lane >> 3) + 8 * j; const LAS float* s = scr + (8 * c) * 33 + n;
        v4u o; o.x = pk2(s[0 * 33], s[1 * 33]); o.y = pk2(s[2 * 33], s[3 * 33]); o.z = pk2(s[4 * 33], s[5 * 33]); o.w = pk2(s[6 * 33], s[7 * 33]);
        *(GAS v4u*)(WT + (size_t)(CPERM ? conv_col_perm(n0 + n) : n0 + n) * ldw + k0 + 8 * c) = o; }
    LDS_WAIT(); asm volatile("" ::: "memory");
}
__device__ __forceinline__ void sincos_d(float angf, float& s_out, float& c_out) {
    const double a = (double)angf;
    const double kq = rint(a * 0.63661977236758134308);
    double r = fma(-kq, 1.57079632679489655800e+00, a); r = fma(-kq, 6.12323399573676603587e-17, r);
    const double r2 = r * r;
    double sp = -7.6471637318198164759e-13; sp = fma(sp, r2, 1.6059043836821614599e-10); sp = fma(sp, r2, -2.5052108385441718775e-08); sp = fma(sp, r2, 2.7557319223985890653e-06);
    sp = fma(sp, r2, -1.9841269841269841270e-04); sp = fma(sp, r2, 8.3333333333333333333e-03); sp = fma(sp, r2, -1.6666666666666666667e-01); const double sn = fma(sp * r2, r, r);
    double cp = 4.7794773323873852974e-14; cp = fma(cp, r2, -1.1470745597729724714e-11); cp = fma(cp, r2, 2.0876756987868098979e-09); cp = fma(cp, r2, -2.7557319223985890653e-07);
    cp = fma(cp, r2, 2.4801587301587301587e-05); cp = fma(cp, r2, -1.3888888888888888889e-03); cp = fma(cp, r2, 4.1666666666666666667e-02); cp = fma(cp, r2, -0.5); const double cs = fma(cp, r2, 1.0);
    const int q = ((int)kq) & 3;
    const double S = (q == 0) ? sn : (q == 1) ? cs : (q == 2) ? -sn : -cs;
    const double C = (q == 0) ? cs : (q == 1) ? -sn : (q == 2) ? -cs : sn;
    s_out = (float)S; c_out = (float)C;
}

template <int MASK> __device__ __forceinline__ void convert_weights(Frame& F, int gw, int nw) {
    LAS float* scr = (LAS float*)(F.lds + RING_OFF + F.wave * 16384);
    constexpr int I_RI = (DM / 64) * (NRI / 32), I_RO = (RV / 64) * (DM / 32), I_CI = (DM / 64) * (NCI / 32), I_CO = (DM / 64) * (DM / 32);
    int lane = F.lane; asm volatile("" : "+v"(lane));
#pragma unroll
    for (int j = 0; j < 2; ++j) {
        if (MASK & (1 << (4 * j + 0))) for (int r = gw; r < I_RI; r += nw) p0_transpose_item(F.w_ret_in + (size_t)j * DM * NRI, DM, NRI, F.Wri + (size_t)j * NRI * LD_X, LD_X, scr, r, lane);
        if (MASK & (1 << (4 * j + 1))) for (int r = gw; r < I_RO; r += nw) p0_transpose_item(F.w_ret_out + (size_t)j * RV * DM, RV, DM, F.Wro + (size_t)j * DM * LD_A2, LD_A2, scr, r, lane);
        if (MASK & (1 << (4 * j + 2))) for (int r = gw; r < I_CI; r += nw) p0_transpose_item<true>(F.w_conv_in + (size_t)j * DM * NCI, DM, NCI, F.Wci + (size_t)j * NCI * LD_X, LD_X, scr, r, lane);
        if (MASK & (1 << (4 * j + 3))) for (int r = gw; r < I_CO; r += nw) p0_transpose_item(F.w_conv_out + (size_t)j * DM * DM, DM, DM, F.Wco + (size_t)j * DM * LD_X, LD_X, scr, r, lane);
    }
}
template <int MASK> __device__ __forceinline__ void convert_by_idle(Frame& F, int n_busy) {
    const int c = (int)blockIdx.x;
    if (MASK != 0 && c >= n_busy && F.G == 256) { F.lane = (int)__builtin_amdgcn_mbcnt_hi(~0u, __builtin_amdgcn_mbcnt_lo(~0u, 0u)); convert_weights<MASK>(F, (c - n_busy) * NWAVES + F.wave, (F.G - n_busy) * NWAVES); }
}
__device__ __forceinline__ void p0_prologue(Frame& F, const float* freq) {
    const int gw = F.vcu * NWAVES + F.wave, NGW = F.G * NWAVES;
    if (F.G == 256) convert_weights<W_IN_PROLOGUE>(F, gw, NGW); else convert_weights<W_ALL>(F, gw, NGW);
    for (int m = gw; m < M_PAD; m += NGW) {
        const float* src = m < ROW_S0 ? F.x_prompt + (size_t)m * DM : (m < ROW_M0 ? F.x_sample + (size_t)(m - ROW_S0) * DM : (m < M_REAL ? F.meta + (size_t)(m - ROW_M0) * DM : nullptr));
        v2u* xb = (v2u*)(F.XB + (size_t)m * LD_X) + F.lane;
#pragma unroll
        for (int j = 0; j < 8; ++j) { const f32x4 v = src ? ((const f32x4*)src)[F.lane + 64 * j] : (f32x4){0.f, 0.f, 0.f, 0.f}; v2u o; o.x = pk2(v.x, v.y); o.y = pk2(v.z, v.w); xb[64 * j] = o; }
    }
    const int gt = F.vcu * NWAVES * 64 + F.tid, NGT = F.G * NWAVES * 64;
    for (int i = gt; i < NPOS * 128; i += NGT) {
        const int p = i >> 7, d = i & 127; const int pos = p < NMETA + SEQ ? p : PAST + (p - (NMETA + SEQ));
        const float ang = (float)pos * freq[d]; float s, c; sincos_d(ang, s, c);
        F.ROPE[i] = c; F.ROPE[NPOS * 128 + i] = s;
    }
    if (gt < 128) { float s, c; sincos_d(16.0f * freq[gt], s, c); F.ROPE[2 * NPOS * 128 + gt] = c; F.ROPE[2 * NPOS * 128 + 128 + gt] = s; }
}

struct EpiResBf16 {
    static constexpr bool PERM = true, AFTER_DRAIN = false;
    bf16* C; const bf16* R; float* P; float alpha;
    __device__ __forceinline__ void operator()(const pg8::f32x4 (&acc)[2][2][4][2], const pg8::Unit& u, int wr, int wc, int fr, int fq) const {
        const int row0 = u.pm * pg8::BM + wr * 64 + fr, col0 = pg8::unit_pn(u) * pg8::BM + wc * 32 + 8 * fq, part = pg8::unit_part(u);
        if (part < 0) {
            v4u rr[2][4][2];
#pragma unroll
            for (int ai = 0; ai < 2; ++ai)
#pragma unroll
                for (int m = 0; m < 4; ++m)
#pragma unroll
                    for (int bj = 0; bj < 2; ++bj) rr[ai][m][bj] = *(const v4u*)(R + (size_t)(row0 + ai * pg8::HALF + m * 16) * LD_X + col0 + bj * pg8::HALF);
            asm volatile("" ::: "memory");
#pragma unroll
            for (int ai = 0; ai < 2; ++ai)
#pragma unroll
                for (int m = 0; m < 4; ++m) { const size_t off = (size_t)(row0 + ai * pg8::HALF + m * 16) * LD_X + col0;
#pragma unroll
                    for (int bj = 0; bj < 2; ++bj) { const v4u r = rr[ai][m][bj];
                        const pg8::f32x4 v0 = acc[ai][bj][m][0] + (pg8::f32x4){bf_lo(r.x), bf_hi(r.x), bf_lo(r.y), bf_hi(r.y)} * alpha, v1 = acc[ai][bj][m][1] + (pg8::f32x4){bf_lo(r.z), bf_hi(r.z), bf_lo(r.w), bf_hi(r.w)} * alpha;
                        pg8::u32x4 w; w.x = pg8::cvt_pk_bf16(v0[0], v0[1]); w.y = pg8::cvt_pk_bf16(v0[2], v0[3]); w.z = pg8::cvt_pk_bf16(v1[0], v1[1]); w.w = pg8::cvt_pk_bf16(v1[2], v1[3]);
                        *(pg8::u32x4*)(C + off + bj * pg8::HALF) = w; } }
        } else {
            bf16* Pp = (bf16*)P + (size_t)part * (M_PAD - ROW_S0) * DM;
#pragma unroll
            for (int ai = 0; ai < 2; ++ai)
#pragma unroll
                for (int m = 0; m < 4; ++m) { const size_t off = (size_t)(row0 - ROW_S0 + ai * pg8::HALF + m * 16) * DM + col0;
#pragma unroll
                    for (int bj = 0; bj < 2; ++bj) { const pg8::f32x4 v0 = acc[ai][bj][m][0], v1 = acc[ai][bj][m][1];
                        pg8::u32x4 w; w.x = pg8::cvt_pk_bf16(v0[0], v0[1]); w.y = pg8::cvt_pk_bf16(v0[2], v0[3]); w.z = pg8::cvt_pk_bf16(v1[0], v1[1]); w.w = pg8::cvt_pk_bf16(v1[2], v1[3]);
                        *(pg8::u32x4*)(Pp + off + bj * pg8::HALF) = w; } }
        }
    }
};

__device__ __forceinline__ f32x4 row_ror1(const f32x4 v) { f32x4 r;
#pragma unroll
    for (int j = 0; j < 4; ++j) { const float t = v[j]; r[j] = __int_as_float(__builtin_amdgcn_update_dpp(0, __float_as_int(t), 0x121, 0xf, 0xf, false)); }
    return r; }
__device__ __forceinline__ f32x4 row_ror2(const f32x4 v) { f32x4 r;
#pragma unroll
    for (int j = 0; j < 4; ++j) { const float t = v[j]; r[j] = __int_as_float(__builtin_amdgcn_update_dpp(0, __float_as_int(t), 0x122, 0xf, 0xf, false)); }
    return r; }
struct EpiConvGate {
    static constexpr bool PERM = true, AFTER_DRAIN = false;
    bf16* O; float* sp; float* ss;
    bf16* A; const float* cw; LAS float* xl;
    __device__ __forceinline__ void operator()(const pg8::f32x4 (&acc)[2][2][4][2], const pg8::Unit& u, int wr, int wc, int fr, int fq) const {
        const int row0 = u.pm * pg8::BM + wr * 64 + fr, e0 = 64 * u.pn + 16 * wc + 4 * fq;
        if (u.pm < ROW_S0 / pg8::BM) {
            const pg8::f32x4 w0 = *(const pg8::f32x4*)(cw + e0), w1 = *(const pg8::f32x4*)(cw + DM + e0), w2 = *(const pg8::f32x4*)(cw + 2 * DM + e0);
            pg8::f32x4 uu[2][4];
#pragma unroll
            for (int ai = 0; ai < 2; ++ai)
#pragma unroll
                for (int m = 0; m < 4; ++m) uu[ai][m] = acc[ai][0][m][1] * acc[ai][1][m][0];
            if (fr >= 14) {
#pragma unroll
                for (int ai = 0; ai < 2; ++ai) *(LAS pg8::f32x4*)(xl + (size_t)(((((wr * 4 + wc) * 2 + ai) * 2 + (fr - 14)) * 4 + fq) * 4)) = uu[ai][3];
            }
            { const int t = (row0 + pg8::HALF + 48) & (SEQ - 1);
              if (t >= SEQ - 2) *(pg8::f32x4*)(sp + ((size_t)((row0 + pg8::HALF + 48) >> 11) * 2 + (t - (SEQ - 2))) * DM + e0) = uu[1][3]; }
            LDS_WAIT(); __builtin_amdgcn_s_barrier(); asm volatile("" ::: "memory");
#pragma unroll
            for (int ai = 0; ai < 2; ++ai) {
                const int B = 2 * ai + wr;
                pg8::f32x4 P = {0.f, 0.f, 0.f, 0.f};
                if (B > 0 && fr >= 14) P = *(const LAS pg8::f32x4*)(xl + (size_t)((((((1 - wr) * 4 + wc) * 2 + (wr ? ai : ai - 1)) * 2 + (fr - 14)) * 4 + fq) * 4));
#pragma unroll
                for (int m = 0; m < 4; ++m) { const int row = row0 + ai * pg8::HALF + m * 16;
                    const pg8::f32x4 U = uu[ai][m], Pm = m == 0 ? P : uu[ai][m - 1];
                    const pg8::f32x4 a1 = row_ror1(U), b1 = row_ror1(Pm), a2 = row_ror2(U), b2 = row_ror2(Pm);
                    const pg8::f32x4 u1 = fr >= 1 ? a1 : b1, u2 = fr >= 2 ? a2 : b2;
                    const pg8::f32x4 b = acc[ai][0][m][0], z = acc[ai][1][m][1]; pg8::f32x4 g2, r;
#pragma unroll
                    for (int j = 0; j < 4; ++j) { g2[j] = z[j] * __builtin_amdgcn_rcpf(1.0f + __expf(-z[j])) * b[j]; r[j] = g2[j] * (w0[j] * u2[j] + w1[j] * u1[j] + w2[j] * U[j]); }
                    v2u w; w.x = pg8::cvt_pk_bf16(r[0], r[1]); w.y = pg8::cvt_pk_bf16(r[2], r[3]); *(v2u*)(A + (size_t)row * LD_X + e0) = w;
                    if ((B == 0 && m == 0 && fr < 2) || (B == 3 && m == 3 && fr >= 14)) { bf16* rp = O + (size_t)row * LD_PROJ + e0;
                        w.x = pg8::cvt_pk_bf16(U[0], U[1]); w.y = pg8::cvt_pk_bf16(U[2], U[3]); *(v2u*)rp = w;
                        w.x = pg8::cvt_pk_bf16(g2[0], g2[1]); w.y = pg8::cvt_pk_bf16(g2[2], g2[3]); *(v2u*)(rp + DM) = w; }
                }
            }
            return;
        }
#pragma unroll
        for (int ai = 0; ai < 2; ++ai)
#pragma unroll
            for (int m = 0; m < 4; ++m) { const int row = row0 + ai * pg8::HALF + m * 16;
                const pg8::f32x4 b = acc[ai][0][m][0], c = acc[ai][0][m][1], v = acc[ai][1][m][0], z = acc[ai][1][m][1];
                const pg8::f32x4 uu = c * v; pg8::f32x4 g2;
#pragma unroll
                for (int j = 0; j < 4; ++j) g2[j] = z[j] * __builtin_amdgcn_rcpf(1.0f + __expf(-z[j])) * b[j];
                bf16* rp = O + (size_t)row * LD_PROJ + e0;
                v2u w; w.x = pg8::cvt_pk_bf16(uu[0], uu[1]); w.y = pg8::cvt_pk_bf16(uu[2], uu[3]); *(v2u*)rp = w;
                w.x = pg8::cvt_pk_bf16(g2[0], g2[1]); w.y = pg8::cvt_pk_bf16(g2[2], g2[3]); *(v2u*)(rp + DM) = w;
                if (row >= ROW_S0 && row < ROW_M0) { const int s = (row - ROW_S0) & (DSEQ - 1); if (s >= DSEQ - 2) *(pg8::f32x4*)(ss + ((size_t)((row - ROW_S0) >> 3) * 2 + (s - (DSEQ - 2))) * DM + e0) = uu; }
            }
    }
};

struct EpiRopeBf16 {
    static constexpr bool PERM = true, AFTER_DRAIN = false;
    pg8::bf16_t* O; int ldc; const float* rope; pg8::bf16_t* QT;
    __device__ __forceinline__ void operator()(const pg8::f32x4 (&acc)[2][2][4][2], const pg8::Unit& u, int wr, int wc, int fr, int fq) const {
        const int row0 = u.pm * pg8::BM + wr * 64 + fr, col0 = u.pn * pg8::BM + wc * 32 + 8 * fq;
        if (u.pn < 16) {
            const bool isq = u.pn < 8; const int d0 = wc * 32 + 8 * fq;
            const float lgh = log2f(1.0f - exp2f(-5.0f - (float)(u.pn & 7)));
            const bool prow = u.pm < ROW_S0 / pg8::BM;
            pg8::f32x4 C0 = {1.f, 1.f, 1.f, 1.f}, C1 = C0, S0 = {0.f, 0.f, 0.f, 0.f}, S1 = S0;
            if (prow) { const float* stp = rope + (size_t)2 * NPOS * 128 + d0; C0 = *(const pg8::f32x4*)stp; C1 = *(const pg8::f32x4*)(stp + 4); S0 = *(const pg8::f32x4*)(stp + 128); S1 = *(const pg8::f32x4*)(stp + 132); }
            pg8::f32x4 cb0[2], cb1[2], sb0[2], sb1[2];
#pragma unroll
            for (int ai = 0; ai < 2; ++ai) { const float* ct = rope + (size_t)row_pos_idx(row0 + ai * pg8::HALF) * 128 + d0; const float* st = ct + (size_t)NPOS * 128;
                cb0[ai] = *(const pg8::f32x4*)ct; cb1[ai] = *(const pg8::f32x4*)(ct + 4); sb0[ai] = *(const pg8::f32x4*)st; sb1[ai] = *(const pg8::f32x4*)(st + 4); }
#pragma unroll
            for (int ai = 0; ai < 2; ++ai) {
                pg8::f32x4 rc0 = cb0[ai], rc1 = cb1[ai], rs0 = sb0[ai], rs1 = sb1[ai];
#pragma unroll
                for (int m = 0; m < 4; ++m) { const int row = row0 + ai * pg8::HALF + m * 16;
                    if (m > 0) { const pg8::f32x4 t0 = rc0 * C0 - rs0 * S0, t1 = rc1 * C1 - rs1 * S1; rs0 = rs0 * C0 + rc0 * S0; rs1 = rs1 * C1 + rc1 * S1; rc0 = t0; rc1 = t1; }
                    const int ci = row < ROW_S0 ? (row & 127) : (row >= ROW_M0 && row < M_REAL ? 112 + (row - ROW_M0) : 0);
                    const float sc = isq ? 0.0625f * __builtin_amdgcn_exp2f(lgh * (float)ci) : __builtin_amdgcn_exp2f(-lgh * (float)ci);
                    const pg8::f32x4 c0 = rc0 * sc, c1 = rc1 * sc, s0 = rs0 * sc, s1 = rs1 * sc;
                    const pg8::f32x4 a0 = acc[ai][0][m][0], a1 = acc[ai][0][m][1], b0 = acc[ai][1][m][0], b1 = acc[ai][1][m][1];
                    const pg8::f32x4 x0 = a0 * c0 - b0 * s0, x1 = a1 * c1 - b1 * s1, y0 = a0 * s0 + b0 * c0, y1 = a1 * s1 + b1 * c1;
                    const bool toqt = isq && (row < ROW_S0 || row >= ROW_M0);
                    const int ci2 = row < ROW_S0 ? (row & 127) : 112 + (row - ROW_M0);
                    const size_t blk = row < ROW_S0 ? (size_t)(((row >> 11) * NH + (u.pn & 7)) * 16 + ((row & 2047) >> 7)) * 4 + (ci2 >> 5) : (size_t)NBATCH * NH * 16 * 4 + (row < M_REAL ? 0 : NH) + (u.pn & 7);
                    pg8::bf16_t* qb = QT + blk * 8192 + ((size_t)((2 * wc + (fq >> 1)) * 64 + (fq & 1) * 32 + (ci2 & 31))) * 8;
                    pg8::bf16_t* pp = O + (size_t)row * ldc + col0;
                    pg8::bf16_t* p1 = toqt ? qb : pp; pg8::bf16_t* p2 = toqt ? qb + 8 * 64 * 8 : pp + pg8::HALF;
                    pg8::u32x4 w; w.x = pg8::cvt_pk_bf16(x0[0], x0[1]); w.y = pg8::cvt_pk_bf16(x0[2], x0[3]); w.z = pg8::cvt_pk_bf16(x1[0], x1[1]); w.w = pg8::cvt_pk_bf16(x1[2], x1[3]);
                    *(pg8::u32x4*)p1 = w;
                    w.x = pg8::cvt_pk_bf16(y0[0], y0[1]); w.y = pg8::cvt_pk_bf16(y0[2], y0[3]); w.z = pg8::cvt_pk_bf16(y1[0], y1[1]); w.w = pg8::cvt_pk_bf16(y1[2], y1[3]);
                    *(pg8::u32x4*)p2 = w; }
            }
        } else {
#pragma unroll
            for (int ai = 0; ai < 2; ++ai)
#pragma unroll
                for (int m = 0; m < 4; ++m) { pg8::bf16_t* rowp = O + (size_t)(row0 + ai * pg8::HALF + m * 16) * ldc + col0;
#pragma unroll
                    for (int bj = 0; bj < 2; ++bj) { const pg8::f32x4 v0 = acc[ai][bj][m][0], v1 = acc[ai][bj][m][1];
                        pg8::u32x4 w; w.x = pg8::cvt_pk_bf16(v0[0], v0[1]); w.y = pg8::cvt_pk_bf16(v0[2], v0[3]); w.z = pg8::cvt_pk_bf16(v1[0], v1[1]); w.w = pg8::cvt_pk_bf16(v1[2], v1[3]);
                        *(pg8::u32x4*)(rowp + bj * pg8::HALF) = w; } }
        }
    }
};

typedef float f32x2 __attribute__((ext_vector_type(2)));
struct SamplePre { v4u qk, v, g; };
__device__ __forceinline__ void sample_prefetch(Frame& F, int b, int h, SamplePre& p) {
    const int l = F.tid >> 6, c8 = F.tid & 63; const bf16* pr = F.PROJ + (size_t)(ROW_S0 + b * DSEQ + l) * LD_PROJ;
    p.qk = *(const v4u*)(pr + (c8 < 32 ? 0 : RQK) + h * DK + (c8 & 31) * 8);
    p.v = *(const v4u*)(pr + 2 * RQK + h * DV + c8 * 8);
    p.g = *(const v4u*)(pr + 2 * RQK + RV + h * DV + c8 * 8);
}
template <int VAR = 0, int PF = 8> __device__ __forceinline__ void retention_sample_unit(Frame& F, int lj, int b, int h, const SamplePre& pre) {
    LAS float* kq = (LAS float*)(F.lds + RING_OFF);
    LAS float* vl = (LAS float*)(F.lds + RING_OFF + 16384);
    LAS float* op = (LAS float*)(F.lds + RING_OFF + 32768);
    LAS float* Am = (LAS float*)(F.lds + RING_OFF + 98304);
    const float lg = log2f(1.0f - exp2f(-5.0f - (float)h));
    const int row0 = ROW_S0 + b * DSEQ;
    {
        const int l = F.tid >> 6, c8 = F.tid & 63; const bool isq = c8 < 32; const int d0 = (c8 & 31) * 8;
        const v4u w = pre.qk;
        const float sc = exp2f(lg * (isq ? (float)(l + 1) : (float)(7 - l)));
        const float e[8] = {bf_lo(w.x), bf_hi(w.x), bf_lo(w.y), bf_hi(w.y), bf_lo(w.z), bf_hi(w.z), bf_lo(w.w), bf_hi(w.w)};
#pragma unroll
        for (int j = 0; j < 8; ++j) kq[(d0 + j) * 16 + (isq ? 8 + l : l)] = e[j] * sc;
        const v4u wv = pre.v;
        LAS float* vd = vl + l * 512 + c8 * 8;
        vd[0] = bf_lo(wv.x); vd[1] = bf_hi(wv.x); vd[2] = bf_lo(wv.y); vd[3] = bf_hi(wv.y); vd[4] = bf_lo(wv.z); vd[5] = bf_hi(wv.z); vd[6] = bf_lo(wv.w); vd[7] = bf_hi(wv.w);
    }
    __syncthreads();
    {
        const int p = F.tid >> 3, part = F.tid & 7, l = p >> 3, m = p & 7; float a = 0.f;
        for (int d = part * 32; d < part * 32 + 32; ++d) a += kq[d * 16 + 8 + l] * kq[d * 16 + m];
        a += __shfl_xor(a, 1); a += __shfl_xor(a, 2); a += __shfl_xor(a, 4);
        if (part == 0) Am[p] = m <= l ? a * exp2f(-8.0f * lg) : 0.f;
    }
    const int rg = F.wave >> 1, vq = F.tid & 127;
    const float g8 = exp2f(8.0f * lg);
    f32x4 vv[8], o[8];
#pragma unroll
    for (int l = 0; l < 8; ++l) { vv[l] = *(const LAS f32x4*)(vl + l * 512 + 4 * vq); o[l] = (f32x4){0.f, 0.f, 0.f, 0.f}; }
    const size_t sbase = ((size_t)(lj * DBATCH + b) * NH + h) * DK * DV + (size_t)(rg * 64) * DV + 4 * vq;
    const f32x4* sp = (const f32x4*)(F.state_ret + sbase); f32x4* so = (f32x4*)(F.out + O_SRS + sbase);
    f32x4 buf[PF];
#pragma unroll
    for (int u = 0; u < PF; ++u) buf[u] = __builtin_nontemporal_load(sp + (size_t)u * (DV / 4));
    for (int i0 = 0; i0 < 64; i0 += PF) {
#pragma unroll
        for (int u = 0; u < PF; ++u) {
            const f32x4 s = buf[u];
            if (i0 + PF < 64) buf[u] = __builtin_nontemporal_load(sp + (size_t)(i0 + PF + u) * (DV / 4));
            if (VAR == 1) { o[0] += s; __builtin_nontemporal_store(s * g8, so + (size_t)(i0 + u) * (DV / 4)); continue; }
            if (VAR == 2) { o[0] += s; continue; }
            const LAS f32x4* kr = (const LAS f32x4*)(kq + (rg * 64 + i0 + u) * 16);
            const f32x4 k03 = kr[0], k47 = kr[1], q03 = kr[2], q47 = kr[3];
            o[0] += s * q03.x; o[1] += s * q03.y; o[2] += s * q03.z; o[3] += s * q03.w; o[4] += s * q47.x; o[5] += s * q47.y; o[6] += s * q47.z; o[7] += s * q47.w;
            f32x4 sn = s * g8;
            sn += vv[0] * k03.x; sn += vv[1] * k03.y; sn += vv[2] * k03.z; sn += vv[3] * k03.w; sn += vv[4] * k47.x; sn += vv[5] * k47.y; sn += vv[6] * k47.z; sn += vv[7] * k47.w;
            __builtin_nontemporal_store(sn, so + (size_t)(i0 + u) * (DV / 4));
        }
    }
#pragma unroll
    for (int l = 0; l < 8; ++l) *(LAS f32x4*)(op + (rg * 8 + l) * 512 + 4 * vq) = o[l];
    __syncthreads();
    {
        const int l = F.wave, v0 = 8 * F.lane; float y[8];
#pragma unroll
        for (int j = 0; j < 8; ++j) y[j] = 0.f;
#pragma unroll
        for (int r = 0; r < 4; ++r) { const f32x4 a = *(const LAS f32x4*)(op + (r * 8 + l) * 512 + v0), c = *(const LAS f32x4*)(op + (r * 8 + l) * 512 + v0 + 4);
            y[0] += a.x; y[1] += a.y; y[2] += a.z; y[3] += a.w; y[4] += c.x; y[5] += c.y; y[6] += c.z; y[7] += c.w; }
        for (int m = 0; m <= l; ++m) { const float am = Am[l * 8 + m]; const f32x4 a = *(const LAS f32x4*)(vl + m * 512 + v0), c = *(const LAS f32x4*)(vl + m * 512 + v0 + 4);
            y[0] += am * a.x; y[1] += am * a.y; y[2] += am * a.z; y[3] += am * a.w; y[4] += am * c.x; y[5] += am * c.y; y[6] += am * c.z; y[7] += am * c.w; }
        float s1 = 0.f;
#pragma unroll
        for (int j = 0; j < 8; ++j) s1 += y[j];
        const float mu = wave_sum(s1) * (1.f / DV); float s2 = 0.f;
#pragma unroll
        for (int j = 0; j < 8; ++j) { y[j] -= mu; s2 += y[j] * y[j]; }
        const float rs = 1.0f / sqrtf(wave_sum(s2) * (1.f / DV) + GN_EPS);
        const v4u gw4 = pre.g;
        const float g[8] = {bf_lo(gw4.x), bf_hi(gw4.x), bf_lo(gw4.y), bf_hi(gw4.y), bf_lo(gw4.z), bf_hi(gw4.z), bf_lo(gw4.w), bf_hi(gw4.w)};
        float r[8];
#pragma unroll
        for (int j = 0; j < 8; ++j) r[j] = g[j] / (1.0f + __expf(-g[j])) * (y[j] * rs);
        v4u w; w.x = pk2(r[0], r[1]); w.y = pk2(r[2], r[3]); w.z = pk2(r[4], r[5]); w.w = pk2(r[6], r[7]);
        *(v4u*)(F.A2 + (size_t)(row0 + l) * LD_A2 + h * DV + v0) = w;
    }
    __syncthreads();
}
typedef float f32x16 __attribute__((ext_vector_type(16)));
typedef short s16x8 __attribute__((ext_vector_type(8)));
typedef short s16x4 __attribute__((ext_vector_type(4)));
typedef short v4i16_t __attribute__((ext_vector_type(4)));
typedef __bf16 bf16x2_t __attribute__((ext_vector_type(2)));
__device__ __forceinline__ unsigned cvtpk(float lo, float hi) { const f32x2 v = {lo, hi}; return __builtin_bit_cast(unsigned, __builtin_convertvector(v, bf16x2_t)); }
__device__ __forceinline__ int crow(int r, int hk) { return (r & 3) + 8 * (r >> 2) + 4 * hk; }
__device__ __forceinline__ unsigned off_b(unsigned row, unsigned ch) { return 256u * row + 16u * (ch ^ (((row & 3u) << 2) | ((row >> 2) & 3u))); }
__device__ __forceinline__ unsigned offv(unsigned m, unsigned ch) { return 128u * m + 16u * (ch ^ (((m >> 1) & 1u) << 2)); }
__device__ __forceinline__ s16x4 tr_read(LAS unsigned char* p) { return __builtin_bit_cast(s16x4, __builtin_amdgcn_ds_read_tr16_b64_v4i16((LAS v4i16_t*)p)); }
__device__ __forceinline__ int tok_row(int c, int i, int b) { const int t = 128 * c + i - 112; return t < 0 ? -1 : (t < NMETA ? ROW_M0 + t : b * SEQ + (t - NMETA)); }
#define MFMA32(a, b, c) __builtin_amdgcn_mfma_f32_32x32x16_bf16((a), (b), (c), 0, 0, 0)
#define RP_LANES() int lane_ = (int)__builtin_amdgcn_mbcnt_hi(~0u, __builtin_amdgcn_mbcnt_lo(~0u, 0u)); asm volatile("" : "+v"(lane_)); const int lr = lane_ & 31, hk = lane_ >> 5, blk = (lane_ >> 4) & 1, q4 = (lane_ & 15) >> 2, p4 = lane_ & 3; const unsigned trsub = 8u * (p4 & 1); (void)lr; (void)hk; (void)blk; (void)q4; (void)trsub
#define RP_TID() int tid_ = (int)__builtin_amdgcn_mbcnt_hi(~0u, __builtin_amdgcn_mbcnt_lo(~0u, 0u)); asm volatile("" : "+v"(tid_)); tid_ += 64 * w
#define RP_SB() __builtin_amdgcn_sched_barrier(0)
__device__ __forceinline__ void rp_dma_kv(LAS unsigned char* KI, LAS unsigned char* VI, const bf16* Pk, const bf16* Pv, const void* zero16, int cc, int b, int w, int lane) {
#pragma unroll
    for (int i = 0; i < 8; ++i) { const int piece = w * 8 + i;
        const int dh = piece >> 5, r = 4 * (piece & 31) + (lane >> 4), pc = lane & 15, ch = pc ^ (((r & 3) << 2) | ((r >> 2) & 3));
        const int row = tok_row(cc, r, b);
        const void* g = row >= 0 ? (const void*)(Pk + (size_t)row * LD_PROJ + dh * 128 + 8 * ch) : zero16;
        __builtin_amdgcn_global_load_lds((const unsigned*)g, (LAS unsigned*)(KI + piece * 1024), 16, 0, 0); }
#pragma unroll
    for (int i = 0; i < 2; ++i) { const int piece = w * 2 + i;
        const int m = 8 * piece + (lane >> 3), pc = lane & 7, ch = pc ^ (((m >> 1) & 1) << 2);
        const int row = tok_row(cc, m, b);
        const void* g = row >= 0 ? (const void*)(Pv + (size_t)row * LD_PROJ + 8 * ch) : zero16;
        __builtin_amdgcn_global_load_lds((const unsigned*)g, (LAS unsigned*)(VI + piece * 1024), 16, 0, 0); }
}
template <int SKIP = 0> __device__ __forceinline__ void retention_prompt_mfma_unit(Frame& F, int lj, int uu) {
    LAS unsigned char* KI = F.lds + RING_OFF;
    LAS unsigned char* VI = F.lds + RING_OFF + 65536;
    LAS unsigned char* SI = F.lds + RING_OFF + 81920;
    LAS unsigned char* OT = F.lds + RING_OFF + 114688;
    const int vs = uu & 7, h = (uu >> 3) & 7, b = uu >> 6;
    const int w = F.wave;
    const int lb = w < 4 ? (w >> 1) : 3 - ((w - 4) >> 1), vb = w & 1;
    const float lg = log2f(1.0f - exp2f(-5.0f - (float)h));
    const bf16* Pk = F.PROJ + RQK + h * DK; const bf16* Pv = F.PROJ + 2 * RQK + h * DV + 64 * vs;
    { RP_TID(); for (int i = tid_; i < 32768 / 16; i += NWAVES * 64) *(LAS v4u*)(SI + 16 * i) = (v4u){0u, 0u, 0u, 0u}; }
    f32x16 Sacc[2];
#pragma unroll
    for (int r = 0; r < 16; ++r) { Sacc[0][r] = 0.f; Sacc[1][r] = 0.f; }
    s16x8 Qf[16], Qn[8];
    const void* zero16 = (const void*)((const unsigned char*)F.ctl + 8192);
    { RP_TID(); RP_LANES(); (void)tid_;
      rp_dma_kv(KI, VI, Pk, Pv, zero16, 0, b, w, lane_);
      { const bf16* q0 = F.QT + ((size_t)NBATCH * NH * 16 * 4 + h) * 8192 + lane_ * 8; const bool qv = lb == 3 && lr >= 16;
#pragma unroll
        for (int s = 0; s < 16; ++s) Qf[s] = qv ? *(const s16x8*)(q0 + s * 512) : (s16x8){0, 0, 0, 0, 0, 0, 0, 0}; }
    }
    asm volatile("s_waitcnt vmcnt(0)" ::: "memory");
    __syncthreads();
    for (int c = 0; c < 17; ++c) {
        if (c < 16 && !(SKIP & 8)) { RP_LANES();
          { const bf16* qn = F.QT + ((size_t)(((b * NH + h) * 16 + c) * 4 + lb)) * 8192 + lane_ * 8;
#pragma unroll
            for (int s = 0; s < 8; ++s) Qn[s] = *(const s16x8*)(qn + s * 512); }
        }
        RP_SB();
        f32x16 Oacc;
#pragma unroll
        for (int r = 0; r < 16; ++r) Oacc[r] = 0.f;
        for (int mb = 0; mb <= ((SKIP & 1) ? -1 : lb); ++mb) { RP_LANES();
            f32x16 Sc;
#pragma unroll
            for (int r = 0; r < 16; ++r) Sc[r] = 0.f;
            LAS unsigned char* krow = KI + 256 * (32 * mb + lr); const unsigned xr = ((lr & 3) << 2) | ((lr >> 2) & 3);
#pragma unroll
            for (int s = 0; s < 16; ++s) { const s16x8 a = *(const LAS s16x8*)(krow + (s >> 3) * 32768 + 16 * ((2 * (s & 7) + hk) ^ xr)); Sc = MFMA32(a, Qf[s], Sc); }
            if (mb == lb) {
#pragma unroll
                for (int r = 0; r < 16; ++r) Sc[r] = lr >= crow(r, hk) ? Sc[r] : 0.f;
            }
#pragma unroll
            for (int s2 = 0; s2 < 2; ++s2) {
                v4u pw; pw.x = cvtpk(Sc[8 * s2 + 0], Sc[8 * s2 + 1]); pw.y = cvtpk(Sc[8 * s2 + 2], Sc[8 * s2 + 3]); pw.z = cvtpk(Sc[8 * s2 + 4], Sc[8 * s2 + 5]); pw.w = cvtpk(Sc[8 * s2 + 6], Sc[8 * s2 + 7]);
                const s16x8 Pf = __builtin_bit_cast(s16x8, pw);
                const unsigned m0 = 32 * mb + 16 * s2 + 4 * hk + q4, chv = 4 * vb + 2 * blk + (p4 >> 1);
                const s16x4 lo = tr_read(VI + offv(m0, chv) + trsub), hi = tr_read(VI + offv(m0 + 8, chv) + trsub);
                const s16x8 Va = __builtin_shufflevector(lo, hi, 0, 1, 2, 3, 4, 5, 6, 7);
                Oacc = MFMA32(Va, Pf, Oacc);
            }
        }
        RP_SB();
        { RP_LANES();
            LAS unsigned char* kbase = KI + (w >> 2) * 32768 + trsub; const unsigned chk = 4 * (w & 3) + 2 * blk + (p4 >> 1);
            LAS unsigned char* vbase = VI + trsub; const unsigned chv = 2 * blk + (p4 >> 1);
#pragma unroll
            for (int s = 0; s < ((SKIP & 4) ? 0 : 8); ++s) {
                const unsigned mrow = 16 * s + 8 * hk + q4;
                const s16x4 k0 = tr_read(kbase + off_b(mrow, chk)), k1 = tr_read(kbase + off_b(mrow + 4, chk));
                const s16x8 Ka = __builtin_shufflevector(k0, k1, 0, 1, 2, 3, 4, 5, 6, 7);
#pragma unroll
                for (int v2 = 0; v2 < 2; ++v2) {
                    const s16x4 v0 = tr_read(vbase + offv(mrow, 4 * v2 + chv)), v1 = tr_read(vbase + offv(mrow + 4, 4 * v2 + chv));
                    const s16x8 Vb = __builtin_shufflevector(v0, v1, 0, 1, 2, 3, 4, 5, 6, 7);
                    Sacc[v2] = MFMA32(Ka, Vb, Sacc[v2]);
                }
            }
        }
        RP_SB();
        __syncthreads();
        if (c < 16 && !(SKIP & 16)) { RP_LANES(); rp_dma_kv(KI, VI, Pk, Pv, zero16, c + 1, b, w, lane_); }
        { RP_LANES();
            LAS unsigned char* srow = SI + 256 * (32 * vb + lr); const unsigned xr = ((lr & 3) << 2) | ((lr >> 2) & 3);
            if (!(SKIP & 2)) {
#pragma unroll
            for (int s = 0; s < 16; ++s) { const s16x8 a = *(const LAS s16x8*)(srow + (s >> 3) * 16384 + 16 * ((2 * (s & 7) + hk) ^ xr)); Oacc = MFMA32(a, Qf[s], Oacc); }
            }
          { LAS unsigned char* op = OT + 144 * (32 * lb + lr) + 2 * (32 * vb + 4 * hk);
#pragma unroll
            for (int g4 = 0; g4 < 4; ++g4) { v2u o; o.x = cvtpk(Oacc[4 * g4], Oacc[4 * g4 + 1]); o.y = cvtpk(Oacc[4 * g4 + 2], Oacc[4 * g4 + 3]); *(LAS v2u*)(op + 16 * g4) = o; } }
          if (c < 16 && !(SKIP & 8)) { const bf16* qn = F.QT + ((size_t)(((b * NH + h) * 16 + c) * 4 + lb)) * 8192 + lane_ * 8;
#pragma unroll
            for (int s = 8; s < 16; ++s) Qf[s] = *(const s16x8*)(qn + s * 512); }
        }
        RP_SB();
        asm volatile("s_waitcnt lgkmcnt(0)" ::: "memory"); __builtin_amdgcn_s_barrier(); asm volatile("" ::: "memory");
        { RP_TID();
#pragma unroll
          for (int i = 0; i < 2; ++i) { const int idx = tid_ + 512 * i, r = idx >> 3, ch = idx & 7; const int row = tok_row(c, r, b);
              if (row >= 0 && (c > 0 || b == 0)) *(v4u*)(F.YB + (size_t)row * LD_Y + h * DV + 64 * vs + 8 * ch) = *(const LAS v4u*)(OT + 144 * r + 16 * ch); } }
        { RP_LANES(); RP_TID();
          const float g128 = __builtin_amdgcn_exp2f(128.0f * lg);
#pragma unroll
          for (int r = 0; r < 16; ++r) { Sacc[0][r] *= g128; Sacc[1][r] *= g128; }
#pragma unroll
          for (int v2 = 0; v2 < 2; ++v2)
#pragma unroll
            for (int g4 = 0; g4 < 4; ++g4) { v2u o; o.x = cvtpk(Sacc[v2][4 * g4], Sacc[v2][4 * g4 + 1]); o.y = cvtpk(Sacc[v2][4 * g4 + 2], Sacc[v2][4 * g4 + 3]);
                *(LAS v2u*)(SI + (w >> 2) * 16384 + off_b(32 * v2 + lr, 4 * (w & 3) + g4) + 8 * hk) = o; }
          if (c < 16) {
#pragma unroll
            for (int s = 0; s < 8; ++s) Qf[s] = Qn[s];
          }
        }
        asm volatile("s_waitcnt vmcnt(0)" ::: "memory");
        __syncthreads();
    }
    { RP_LANES(); const float ginv = __builtin_amdgcn_exp2f(-lg);
      float* so = F.out + O_SRP + ((size_t)(lj * NBATCH + b) * NH + h) * DK * DV + 64 * vs + lr;
#pragma unroll
      for (int v2 = 0; v2 < 2; ++v2)
#pragma unroll
          for (int r = 0; r < 16; ++r) so[(size_t)(32 * w + crow(r, hk)) * DV + 32 * v2] = Sacc[v2][r] * ginv; }
    __syncthreads();
}
__device__ __forceinline__ void retention_phase(Frame& F, int lj, int what = 3) {
    const int half = F.G >> 1, me = F.vcu >> 1;
    if (what == 3 && F.G >= 2) {
        if (!(F.vcu & 1)) { for (int u = me; u < NBATCH * NH * 8; u += half) retention_prompt_mfma_unit(F, lj, u); }
        gu32* qhead = F.ctl + CW_QUEUE + 64 * lj;
        F.lane = (int)__builtin_amdgcn_mbcnt_hi(~0u, __builtin_amdgcn_mbcnt_lo(~0u, 0u)); asm volatile("" : "+v"(F.lane)); F.tid = F.wave * 64 + F.lane;
        SamplePre p0, p1;
        __syncthreads();
        if (F.tid == 0) F.MISC[16] = __hip_atomic_fetch_add(qhead, 1u, RLX_AGENT);
        __syncthreads();
        int u0 = (int)F.MISC[16];
        if (u0 < DBATCH * NH) sample_prefetch(F, u0 >> 3, u0 & 7, p0);
        while (u0 < DBATCH * NH) {
            __syncthreads();
            if (F.tid == 0) F.MISC[16] = __hip_atomic_fetch_add(qhead, 1u, RLX_AGENT);
            __syncthreads();
            const int u1 = (int)F.MISC[16];
            if (u1 < DBATCH * NH) sample_prefetch(F, u1 >> 3, u1 & 7, p1);
            retention_sample_unit(F, lj, u0 >> 3, u0 & 7, p0);
            u0 = u1; p0 = p1;
        }
        return;
    }
    if (what == 70) { if (!(F.vcu & 1)) for (int u = me; u < NBATCH * NH * 8; u += half) retention_prompt_mfma_unit(F, lj, u); return; }
    if (what == 71) { if (F.vcu & 1) for (int u = me; u < DBATCH * NH; u += half) { SamplePre pp; sample_prefetch(F, u >> 3, u & 7, pp); retention_sample_unit(F, lj, u >> 3, u & 7, pp); } return; }
    if (what >= 64) { for (int u = F.vcu; u < NBATCH * NH * 8; u += F.G) { if (what == 64) retention_prompt_mfma_unit<1>(F, lj, u); else if (what == 65) retention_prompt_mfma_unit<2>(F, lj, u); else if (what == 66) retention_prompt_mfma_unit<4>(F, lj, u); else if (what == 67) retention_prompt_mfma_unit<8>(F, lj, u); else if (what == 68) retention_prompt_mfma_unit<24>(F, lj, u); else retention_prompt_mfma_unit<0>(F, lj, u); } return; }
    if (what == 8) { for (int u = F.vcu; u < DBATCH * NH; u += F.G) { SamplePre pp; sample_prefetch(F, u >> 3, u & 7, pp); retention_sample_unit<1>(F, lj, u >> 3, u & 7, pp); } return; }
    if (what == 32) { if ((F.vcu & 3) == 3) for (int u = F.vcu >> 2; u < DBATCH * NH; u += F.G >> 2) { SamplePre pp; sample_prefetch(F, u >> 3, u & 7, pp); retention_sample_unit<1, 16>(F, lj, u >> 3, u & 7, pp); } return; }
    if (what == 16) { for (int u = F.vcu; u < DBATCH * NH; u += F.G) { SamplePre pp; sample_prefetch(F, u >> 3, u & 7, pp); retention_sample_unit<2>(F, lj, u >> 3, u & 7, pp); } return; }
    if (what & 1) for (int u = F.vcu; u < NBATCH * NH * 8; u += F.G) retention_prompt_mfma_unit(F, lj, u);
    F.lane = (int)__builtin_amdgcn_mbcnt_hi(~0u, __builtin_amdgcn_mbcnt_lo(~0u, 0u)); asm volatile("" : "+v"(F.lane)); F.tid = F.wave * 64 + F.lane;
    if (what & 2) for (int u = F.vcu; u < DBATCH * NH; u += F.G) { SamplePre pp; sample_prefetch(F, u >> 3, u & 7, pp); retention_sample_unit(F, lj, u >> 3, u & 7, pp); }
}

__device__ __forceinline__ void groupnorm_gate_phase(Frame& F) {
    const int gw = F.vcu * NWAVES + F.wave, NGW = F.G * NWAVES;
    for (int it = gw; it < M_PAD * NH; it += NGW) {
        const int row = it >> 3, h = it & 7;
        v4u* o = (v4u*)(F.A2 + (size_t)row * LD_A2 + h * DV) + F.lane;
        if (row >= ROW_S0 && row < ROW_M0) continue;
        if (row >= M_REAL) { *o = (v4u){0u, 0u, 0u, 0u}; continue; }
        const v4u yw = *((const v4u*)(F.YB + (size_t)row * LD_Y + h * DV) + F.lane);
        const f32x4 y0 = {bf_lo(yw.x), bf_hi(yw.x), bf_lo(yw.y), bf_hi(yw.y)}, y1 = {bf_lo(yw.z), bf_hi(yw.z), bf_lo(yw.w), bf_hi(yw.w)};
        const float mu = wave_sum((y0.x + y0.y) + (y0.z + y0.w) + (y1.x + y1.y) + (y1.z + y1.w)) * (1.f / DV);
        const f32x4 d0 = y0 - mu, d1 = y1 - mu;
        const float var = wave_sum((d0.x * d0.x + d0.y * d0.y) + (d0.z * d0.z + d0.w * d0.w) + (d1.x * d1.x + d1.y * d1.y) + (d1.z * d1.z + d1.w * d1.w)) * (1.f / DV);
        const float rs = 1.0f / sqrtf(var + GN_EPS);
        const v4u gw4 = *((const v4u*)(F.PROJ + (size_t)row * LD_PROJ + 2 * RQK + RV + h * DV) + F.lane);
        float g[8] = {bf_lo(gw4.x), bf_hi(gw4.x), bf_lo(gw4.y), bf_hi(gw4.y), bf_lo(gw4.z), bf_hi(gw4.z), bf_lo(gw4.w), bf_hi(gw4.w)};
        float yn[8] = {d0.x * rs, d0.y * rs, d0.z * rs, d0.w * rs, d1.x * rs, d1.y * rs, d1.z * rs, d1.w * rs};
        float r[8];
#pragma unroll
        for (int j = 0; j < 8; ++j) r[j] = g[j] / (1.0f + __expf(-g[j])) * yn[j];
        v4u w; w.x = pk2(r[0], r[1]); w.y = pk2(r[2], r[3]); w.z = pk2(r[4], r[5]); w.w = pk2(r[6], r[7]);
        *o = w;
    }
}

__device__ __forceinline__ void layernorm_phase(Frame& F, int layer, bool last) {
    const int gw = F.vcu * NWAVES + F.wave, NGW = F.G * NWAVES;
    for (int row = gw; row < M_PAD; row += NGW) {
        float v[4][8]; float s = 0.f;
        if (row < ROW_S0) {
            const v4u* hp = (const v4u*)(F.HB + (size_t)row * LD_X) + F.lane;
#pragma unroll
            for (int j = 0; j < 4; ++j) { const v4u w = hp[64 * j]; v[j][0] = bf_lo(w.x); v[j][1] = bf_hi(w.x); v[j][2] = bf_lo(w.y); v[j][3] = bf_hi(w.y); v[j][4] = bf_lo(w.z); v[j][5] = bf_hi(w.z); v[j][6] = bf_lo(w.w); v[j][7] = bf_hi(w.w); }
        } else {
            const v4u* xp = (const v4u*)(F.XB + (size_t)row * LD_X) + F.lane; const v4u* pp = (const v4u*)((const bf16*)F.PART + (size_t)(row - ROW_S0) * DM) + F.lane;
#pragma unroll
            for (int j = 0; j < 4; ++j) { const v4u w = xp[64 * j];
                f32x4 a0 = (f32x4){bf_lo(w.x), bf_hi(w.x), bf_lo(w.y), bf_hi(w.y)} * DN_ALPHA, a1 = (f32x4){bf_lo(w.z), bf_hi(w.z), bf_lo(w.w), bf_hi(w.w)} * DN_ALPHA;
#pragma unroll
                for (int k = 0; k < TAIL_KS; ++k) { const v4u q = pp[(size_t)k * (M_PAD - ROW_S0) * (DM / 8) + 64 * j];
                    a0 += (f32x4){bf_lo(q.x), bf_hi(q.x), bf_lo(q.y), bf_hi(q.y)}; a1 += (f32x4){bf_lo(q.z), bf_hi(q.z), bf_lo(q.w), bf_hi(q.w)}; }
                v[j][0] = a0.x; v[j][1] = a0.y; v[j][2] = a0.z; v[j][3] = a0.w; v[j][4] = a1.x; v[j][5] = a1.y; v[j][6] = a1.z; v[j][7] = a1.w; }
        }
#pragma unroll
        for (int j = 0; j < 4; ++j)
#pragma unroll
            for (int e = 0; e < 8; ++e) s += v[j][e];
        const float mean = wave_sum(s) * (1.f / DM); float s2 = 0.f;
#pragma unroll
        for (int j = 0; j < 4; ++j)
#pragma unroll
            for (int e = 0; e < 8; ++e) { v[j][e] -= mean; s2 += v[j][e] * v[j][e]; }
        const float rstd = 1.f / sqrtf(wave_sum(s2) * (1.f / DM) + LN_EPS);
        const f32x4* gp = (const f32x4*)(F.ln_g + (size_t)layer * DM) + 2 * F.lane; const f32x4* bp = (const f32x4*)(F.ln_b + (size_t)layer * DM) + 2 * F.lane;
        v4u* xb = (v4u*)(F.XB + (size_t)row * LD_X) + F.lane;
        f32x4* od = nullptr;
        if (last) { if (row < ROW_S0) od = (f32x4*)(F.out + O_YP + (size_t)row * DM) + 2 * F.lane; else if (row < ROW_M0) od = (f32x4*)(F.out + O_YS + (size_t)(row - ROW_S0) * DM) + 2 * F.lane; }
#pragma unroll
        for (int j = 0; j < 4; ++j) { const f32x4 g0 = gp[128 * j], g1 = gp[128 * j + 1], b0 = bp[128 * j], b1 = bp[128 * j + 1];
            const f32x4 y0 = (f32x4){v[j][0], v[j][1], v[j][2], v[j][3]} * rstd * g0 + b0, y1 = (f32x4){v[j][4], v[j][5], v[j][6], v[j][7]} * rstd * g1 + b1;
            if (last) { if (od) { od[128 * j] = y0; od[128 * j + 1] = y1; } }
            else { v4u o; o.x = pk2(y0.x, y0.y); o.y = pk2(y0.z, y0.w); o.z = pk2(y1.x, y1.y); o.w = pk2(y1.z, y1.w); xb[64 * j] = o; } }
    }
}

__device__ __forceinline__ void conv_phase(Frame& F, int lj) {
    const int gt = F.vcu * NWAVES * 64 + F.tid, NGT = F.G * NWAVES * 64;
    const float* cw = F.conv_w + (size_t)lj * 3 * DM;
    for (int it = gt; it < (2 * (ROW_S0 / 256) + M_PAD - ROW_S0) * (DM / 8); it += NGT) {
        const int ri = it >> 8, e0 = (it & 255) * 8; const int row = ri < 2 * (ROW_S0 / 256) ? (ri >> 1) * 256 + (ri & 1) : ROW_S0 + (ri - 2 * (ROW_S0 / 256));
        v4u* o = (v4u*)(F.A2 + (size_t)row * LD_X + e0);
        if (row >= M_REAL) { *o = (v4u){0u, 0u, 0u, 0u}; continue; }
        int r1, r2;
        if (row < ROW_S0) { const int t = row & (SEQ - 1); r1 = t >= 1 ? row - 1 : ROW_M0 + 15; r2 = t >= 2 ? row - 2 : (t == 1 ? ROW_M0 + 15 : ROW_M0 + 14); }
        else if (row < ROW_M0) { const int s = (row - ROW_S0) & (DSEQ - 1); r1 = s >= 1 ? row - 1 : -3; r2 = s >= 2 ? row - 2 : (s == 1 ? -3 : -2); }
        else { const int j = row - ROW_M0; r1 = j >= 1 ? row - 1 : -1; r2 = j >= 2 ? row - 2 : -1; }
        float u0[8], u1[8], u2[8];
        const bf16* pr = F.PROJ + (size_t)row * LD_PROJ + e0;
        { const v4u w = *(const v4u*)pr; u0[0] = bf_lo(w.x); u0[1] = bf_hi(w.x); u0[2] = bf_lo(w.y); u0[3] = bf_hi(w.y); u0[4] = bf_lo(w.z); u0[5] = bf_hi(w.z); u0[6] = bf_lo(w.w); u0[7] = bf_hi(w.w); }
#pragma unroll
        for (int k = 1; k <= 2; ++k) {
            const int rr = k == 1 ? r1 : r2; float* uu = k == 1 ? u1 : u2;
            if (rr >= 0) { const v4u w = *(const v4u*)(F.PROJ + (size_t)rr * LD_PROJ + e0);
                uu[0] = bf_lo(w.x); uu[1] = bf_hi(w.x); uu[2] = bf_lo(w.y); uu[3] = bf_hi(w.y); uu[4] = bf_lo(w.z); uu[5] = bf_hi(w.z); uu[6] = bf_lo(w.w); uu[7] = bf_hi(w.w); }
            else if (rr == -1) {
#pragma unroll
                for (int j = 0; j < 8; ++j) uu[j] = 0.f; }
            else { const int srow = -2 - rr; const int sb = (row - ROW_S0) >> 3; const float* sp = F.state_conv + (((size_t)lj * DBATCH + sb) * 2 + srow) * DM + e0;
                const f32x4 a = *(const f32x4*)sp, bq = *(const f32x4*)(sp + 4); uu[0] = a.x; uu[1] = a.y; uu[2] = a.z; uu[3] = a.w; uu[4] = bq.x; uu[5] = bq.y; uu[6] = bq.z; uu[7] = bq.w; }
        }
        const v4u gg = *(const v4u*)(pr + DM);
        const float gf[8] = {bf_lo(gg.x), bf_hi(gg.x), bf_lo(gg.y), bf_hi(gg.y), bf_lo(gg.z), bf_hi(gg.z), bf_lo(gg.w), bf_hi(gg.w)};
        float r[8];
#pragma unroll
        for (int j = 0; j < 8; ++j) r[j] = gf[j] * (cw[e0 + j] * u2[j] + cw[DM + e0 + j] * u1[j] + cw[2 * DM + e0 + j] * u0[j]);
        v4u w; w.x = pk2(r[0], r[1]); w.y = pk2(r[2], r[3]); w.z = pk2(r[4], r[5]); w.w = pk2(r[6], r[7]); *o = w;
    }
}

#define IN(k) (lo <= (k) && (k) < hi)
#define OPAQUE(p) asm volatile("" : "+s"(p))
#define FRESH() do { F.lane = (int)__builtin_amdgcn_mbcnt_hi(~0u, __builtin_amdgcn_mbcnt_lo(~0u, 0u)); asm volatile("" : "+v"(F.lane)); F.tid = F.wave * 64 + F.lane; asm volatile("" : "+s"(F.vcu)); } while (0)
#define SEAM(k) do { if (IN((k) + 1)) xcd_barrier(bar); } while (0)
#define SEAM2(k) do { if (IN((k) + 2)) xcd_barrier(bar); } while (0)

#ifndef GEMM_ALIGN
#define GEMM_ALIGN true
#endif
#ifndef GEMM_SP2
#define GEMM_SP2 true
#endif
#ifndef MK_PROBE
#define MK_PROBE 0
#endif
#define PROBE_REP(mask, call) do { if ((MK_PROBE) & (mask)) { xcd_barrier(bar); call; } } while (0)
template <int lj> __device__ __forceinline__ void gemm_ret_in(Frame& F) {
    const bf16* gA = F.XB; const bf16* gB = F.Wri + (size_t)lj * NRI * LD_X; OPAQUE(gA); OPAQUE(gB); pg8::Gemm g{gA, gB, M_PAD, NRI, DM, LD_X}; pg8::StaticOrder S; S.init(M_PAD, NRI, DM, F.G, (int)blockIdx.x);
    EpiRopeBf16 E{F.PROJ, LD_PROJ, F.ROPE, F.QT};
    pg8::gemm_phase<EpiRopeBf16, pg8::StaticOrder, GEMM_ALIGN, GEMM_SP2>(F.lds + RING_OFF, g, S, E, F.wave);
}
template <int lj> __device__ __forceinline__ void gemm_ret_out(Frame& F) {
    const bf16* gA = F.A2; const bf16* gB = F.Wro + (size_t)lj * DM * LD_A2; OPAQUE(gA); OPAQUE(gB); pg8::Gemm g{gA, gB, M_PAD, DM, RV, LD_A2}; pg8::TailOrder S; S.init(ROW_S0, M_PAD, DM, g.K, TAIL_KS, F.G, (int)blockIdx.x);
    EpiResBf16 E{F.HB, F.XB, F.PART, DN_ALPHA};
    pg8::gemm_phase<EpiResBf16, pg8::TailOrder, GEMM_ALIGN, GEMM_SP2>(F.lds + RING_OFF, g, S, E, F.wave);
}
template <int lj> __device__ __forceinline__ void gemm_conv_in(Frame& F) {
    const bf16* gA = F.XB; const bf16* gB = F.Wci + (size_t)lj * NCI * LD_X; OPAQUE(gA); OPAQUE(gB); pg8::Gemm g{gA, gB, M_PAD, NCI, DM, LD_X}; pg8::StaticOrder S; S.init(M_PAD, NCI, DM, F.G, (int)blockIdx.x);
    EpiConvGate E{F.PROJ, F.out + O_SCP + (size_t)lj * NBATCH * 2 * DM, F.out + O_SCS + (size_t)lj * DBATCH * 2 * DM, F.A2, F.conv_w + (size_t)lj * 3 * DM, (LAS float*)(F.lds + RING_OFF + 131072)};
    pg8::gemm_phase<EpiConvGate, pg8::StaticOrder, GEMM_ALIGN, GEMM_SP2>(F.lds + RING_OFF, g, S, E, F.wave);
}
template <int lj> __device__ __forceinline__ void gemm_conv_out(Frame& F) {
    const bf16* gA = F.A2; const bf16* gB = F.Wco + (size_t)lj * DM * LD_X; OPAQUE(gA); OPAQUE(gB); pg8::Gemm g{gA, gB, M_PAD, DM, DM, LD_X}; pg8::TailOrder S; S.init(ROW_S0, M_PAD, DM, g.K, TAIL_KS, F.G, (int)blockIdx.x);
    EpiResBf16 E{F.HB, F.XB, F.PART, DN_ALPHA};
    pg8::gemm_phase<EpiResBf16, pg8::TailOrder, GEMM_ALIGN, GEMM_SP2>(F.lds + RING_OFF, g, S, E, F.wave);
}
struct EpiNull { static constexpr bool PERM = true, AFTER_DRAIN = false; float* sink;
    __device__ __forceinline__ void operator()(const pg8::f32x4 (&acc)[2][2][4][2], const pg8::Unit& u, int wr, int wc, int fr, int fq) const { pg8::f32x4 t = {0.f, 0.f, 0.f, 0.f};
#pragma unroll
        for (int a = 0; a < 2; ++a)
#pragma unroll
            for (int b = 0; b < 2; ++b)
#pragma unroll
                for (int m = 0; m < 4; ++m) { t += acc[a][b][m][0]; t += acc[a][b][m][1]; }
        if (t[0] + t[1] + t[2] + t[3] == 123456.789f) sink[0] = 1.f; } };
template <int lj, int which> __device__ __forceinline__ void gemm_null(Frame& F) {
    const bf16* gA = (which == 0 || which == 2) ? F.XB : F.A2;
    const bf16* gB = which == 0 ? F.Wri + (size_t)lj * NRI * LD_X : which == 1 ? F.Wro + (size_t)lj * DM * LD_A2 : which == 2 ? F.Wci + (size_t)lj * NCI * LD_X : F.Wco + (size_t)lj * DM * LD_X;
    OPAQUE(gA); OPAQUE(gB);
    constexpr int N = which == 0 ? NRI : which == 2 ? NCI : DM, K = which == 1 ? RV : DM, LD = which == 1 ? LD_A2 : LD_X;
    pg8::Gemm g{gA, gB, M_PAD, N, K, LD}; EpiNull E{F.PART};
    if (which == 0 || which == 2) { pg8::StaticOrder S; S.init(M_PAD, N, K, F.G, (int)blockIdx.x); pg8::gemm_phase<EpiNull, pg8::StaticOrder, GEMM_ALIGN, GEMM_SP2>(F.lds + RING_OFF, g, S, E, F.wave); }
    else { pg8::TailOrder S; S.init(ROW_S0, M_PAD, N, K, TAIL_KS, F.G, (int)blockIdx.x); pg8::gemm_phase<EpiNull, pg8::TailOrder, GEMM_ALIGN, GEMM_SP2>(F.lds + RING_OFF, g, S, E, F.wave); }
}
constexpr int N_TAIL_UNITS = (M_PAD - ROW_S0) / 256 * (DM / 256) * TAIL_KS;
template <int lj> __device__ __forceinline__ void layer_pair(Frame& F, const XcdBarrier& bar, const int lo, const int hi) {
    const int pb = 1 + 10 * lj;
    if (IN(pb + 0)) { if ((MK_PROBE) & 512) { gemm_null<lj, 0>(F); xcd_barrier(bar); } gemm_ret_in<lj>(F); PROBE_REP(2, gemm_ret_in<lj>(F)); SEAM(pb + 0); }
    if (IN(pb + 2)) { if ((MK_PROBE) & 64) { FRESH(); retention_phase(F, lj, 8); xcd_barrier(bar); } if ((MK_PROBE) & 128) { FRESH(); retention_phase(F, lj, 16); xcd_barrier(bar); } if ((MK_PROBE) & 256) { FRESH(); retention_phase(F, lj, 32); xcd_barrier(bar); } if ((MK_PROBE) >= 1024) { FRESH(); retention_phase(F, lj, 64 + ((MK_PROBE) >> 10) - 1); xcd_barrier(bar); } FRESH(); retention_phase(F, lj); PROBE_REP(4, FRESH(); retention_phase(F, lj)); PROBE_REP(16, FRESH(); retention_phase(F, lj, 1)); PROBE_REP(32, FRESH(); retention_phase(F, lj, 2)); SEAM(pb + 2); }
    if (IN(pb + 3)) { FRESH(); groupnorm_gate_phase(F); PROBE_REP(8, FRESH(); groupnorm_gate_phase(F)); SEAM(pb + 3); }
    if (IN(pb + 4)) { if ((MK_PROBE) & 512) { gemm_null<lj, 1>(F); xcd_barrier(bar); } gemm_ret_out<lj>(F); if (MK_DEFER_CVT) convert_by_idle<(0x4 << (4 * lj))>(F, N_TAIL_UNITS); PROBE_REP(2, gemm_ret_out<lj>(F)); SEAM(pb + 4); }
    if (IN(pb + 5)) { FRESH(); layernorm_phase(F, 2 * lj, false); SEAM(pb + 5); }
    if (IN(pb + 6)) { if ((MK_PROBE) & 512) { gemm_null<lj, 2>(F); xcd_barrier(bar); } gemm_conv_in<lj>(F); if (MK_DEFER_CVT) convert_by_idle<(lj == 0 ? 0x18 : 0x80)>(F, (M_PAD / 256) * (NCI / 256) % 256); PROBE_REP(2, gemm_conv_in<lj>(F)); SEAM(pb + 6); }
    if (IN(pb + 7)) { FRESH(); conv_phase(F, lj); PROBE_REP(8, FRESH(); conv_phase(F, lj)); SEAM(pb + 7); }
    if (IN(pb + 8)) { if ((MK_PROBE) & 512) { gemm_null<lj, 3>(F); xcd_barrier(bar); } gemm_conv_out<lj>(F); if (MK_DEFER_CVT) convert_by_idle<(lj == 0 ? 0x20 : 0)>(F, N_TAIL_UNITS); PROBE_REP(2, gemm_conv_out<lj>(F)); SEAM(pb + 8); }
    if (IN(pb + 9)) { FRESH(); layernorm_phase(F, 2 * lj + 1, lj == 1); SEAM(pb + 9); }
}

constexpr int NPHASE = 21;
struct Args { const float* in[12]; float* out; unsigned char* ws; float freq[128]; int ph_lo, ph_hi; };
__global__ void __launch_bounds__(NWAVES * 64, 2) mk_fwd(Args args) {
    extern __shared__ __attribute__((aligned(16))) unsigned char lds[];
    Frame F;
    F.lds = (LAS unsigned char*)lds;
    F.MISC = (volatile LAS unsigned*)(F.lds + MISC_OFF);
    F.tid = threadIdx.x; F.lane = F.tid & 63; F.wave = __builtin_amdgcn_readfirstlane(F.tid >> 6);
    F.G = gridDim.x; { const int bx = blockIdx.x; F.vcu = (F.G % 8 == 0) ? (bx % 8) * (F.G / 8) + bx / 8 : bx; }
    unsigned char* ws = args.ws;
    F.ctl = (gu32*)(ws + WS_CTL);
    F.x_prompt = args.in[0]; F.x_sample = args.in[1]; F.state_ret = args.in[2]; F.state_conv = args.in[3]; F.meta = args.in[4]; F.w_ret_in = args.in[5];
    F.w_ret_out = args.in[6]; F.w_conv_in = args.in[7]; F.conv_w = args.in[8]; F.w_conv_out = args.in[9]; F.ln_g = args.in[10]; F.ln_b = args.in[11];
    F.out = args.out;
    F.Wri = (bf16*)(ws + WS_WRI); F.Wro = (bf16*)(ws + WS_WRO); F.Wci = (bf16*)(ws + WS_WCI); F.Wco = (bf16*)(ws + WS_WCO);
    F.XB = (bf16*)(ws + WS_XB); F.PROJ = (bf16*)(ws + WS_PROJ); F.A2 = (bf16*)(ws + WS_A2);
    F.HB = (bf16*)(ws + WS_H); F.QT = (bf16*)(ws + WS_XF); F.PART = (float*)(ws + WS_PART); F.YF = (float*)(ws + WS_YF); F.YB = (bf16*)(ws + WS_YF); F.ROPE = (float*)(ws + WS_ROPE);
    for (int u = F.tid; u < (LDS_BYTES - LDSCTL_OFF) / 4; u += NWAVES * 64) ((LAS unsigned*)(F.lds + LDSCTL_OFF))[u] = 0u;
    __syncthreads();
    XcdBarrier bar; bar.bar = (unsigned*)(F.ctl + CW_BAR); bar.x = 0; bar.st = nullptr;
    if (MK_N_LAUNCHES == 1) bar = xcd_barrier_post((unsigned*)(F.ctl + CW_BAR), F.MISC + 8);
    const int lo = args.ph_lo, hi = args.ph_hi;
    if (IN(0)) { FRESH(); p0_prologue(F, args.freq); PROBE_REP(1, FRESH(); p0_prologue(F, args.freq)); SEAM(0); }
    layer_pair<0>(F, bar, lo, hi);
    layer_pair<1>(F, bar, lo, hi);
#undef IN
#undef SEAM
}

extern "C" void kernel_launch(void* const* d_in, const int* in_sizes, int n_in, void* d_out, int out_size, void* d_ws, size_t ws_size, hipStream_t stream) {
    static int grid = 0;
    if (grid == 0) {
        if (n_in != 12 || (size_t)out_size != O_END || ws_size < WS_END) { fprintf(stderr, "kernel_launch: unexpected shapes: n_in %d out %d ws %zu (need %zu)\n", n_in, out_size, ws_size, (size_t)WS_END); grid = -1; return; }
        int dev = 0, cus = 0, per_cu = 0;
        if (hipGetDevice(&dev) != hipSuccess || hipDeviceGetAttribute(&cus, hipDeviceAttributeMultiprocessorCount, dev) != hipSuccess) { grid = -1; return; }
        if (hipFuncSetAttribute((const void*)mk_fwd, hipFuncAttributeMaxDynamicSharedMemorySize, LDS_BYTES) != hipSuccess) { fprintf(stderr, "kernel_launch: hipFuncSetAttribute failed\n"); grid = -1; return; }
        if (hipOccupancyMaxActiveBlocksPerMultiprocessor(&per_cu, (const void*)mk_fwd, NWAVES * 64, LDS_BYTES) != hipSuccess || per_cu < 1) { fprintf(stderr, "kernel_launch: occupancy query says %d blocks per CU\n", per_cu); }
        (void)hipGetLastError();
        grid = cus;
    }
    if (grid < 0) return;
    if (hipMemsetAsync((char*)d_ws + WS_CTL, 0, CTL_ZERO_BYTES, stream) != hipSuccess) { fprintf(stderr, "kernel_launch: memset failed\n"); return; }
    Args a{};
    for (int i = 0; i < 12; ++i) a.in[i] = (const float*)d_in[i];
    a.out = (float*)d_out; a.ws = (unsigned char*)d_ws;
    for (int d = 0; d < 128; ++d) a.freq[d] = (float)pow(10000.0, -(double)d / 128.0);
#if MK_N_LAUNCHES == 1
    a.ph_lo = 0; a.ph_hi = NPHASE;
    hipLaunchKernelGGL(mk_fwd, dim3(grid), dim3(NWAVES * 64), LDS_BYTES, stream, a);
#else
    for (int p = 0; p < NPHASE; ++p) { a.ph_lo = p; a.ph_hi = p + 1; hipLaunchKernelGGL(mk_fwd, dim3(grid), dim3(NWAVES * 64), LDS_BYTES, stream, a); }
#endif
    const hipError_t le = hipPeekAtLastError();
    if (le != hipSuccess) fprintf(stderr, "kernel_launch: launch failed: %s\n", hipGetErrorName(le));
}
```

```cpp
#include <hip/hip_runtime.h>
#include <cstdio>
#include <cstdint>
#include <cmath>
namespace pg8 {
#define PG8_LAS __attribute__((address_space(3)))
typedef unsigned short bf16_t;
typedef short bf16x8 __attribute__((ext_vector_type(8)));
typedef float f32x4 __attribute__((ext_vector_type(4)));
typedef unsigned u32x4 __attribute__((ext_vector_type(4)));
constexpr int BM = 256, BK = 64, HALF = 128, HTB = HALF * BK * 2  , STAGE_BYTES = 8 * HTB, NXCD = 8, WGM = 8;

__host__ __device__ __forceinline__ int lds_byte(int r, int c) { const int st = (r >> 4) * 2 + (c >> 5), rr = r & 15, cc = c & 31, ob = rr * 64 + cc * 2; return st * 1024 + (ob ^ (((ob >> 9) & 1) << 5)); }
__host__ __device__ __forceinline__ void stage_rc(int b, int& R, int& C) { const int st = b / 1024, sb = b % 1024, swz = sb ^ (((sb >> 9) & 1) << 5); R = (st >> 1) * 16 + swz / 64; C = (st & 1) * 32 + (swz % 64) / 2; }
__host__ __device__ __forceinline__ int perm32(int rho) { const int n = rho >> 4, i = rho & 15; return 8 * (i >> 2) + 4 * n + (i & 3); }

struct Unit { int pm, pn; };
__host__ __device__ __forceinline__ int unit_pn(const Unit& u) { return u.pn & 255; }
__host__ __device__ __forceinline__ int unit_part(const Unit& u) { return (u.pn >> 8) - 1; }
struct Gemm { const bf16_t* A; const bf16_t* Bt; int M, N, K, ld; };

struct StaticOrder {
    int nM, nN, nwg, G, c, ntf;
    __host__ __device__ __forceinline__ void init(int M, int N, int K, int G_, int c_) { nM = M / BM; nN = N / BM; nwg = nM * nN; G = G_; c = c_; ntf = K / BK; }
    __host__ __device__ __forceinline__ bool next(int i, Unit& u) const {
        const long L = (long)i * G + c; if (L >= nwg) return false;
        int wgid = (int)L; { const int q = nwg / NXCD, r = nwg % NXCD, xcd = wgid % NXCD, off = wgid / NXCD; wgid = (xcd < r ? xcd * (q + 1) : r * (q + 1) + (xcd - r) * q) + off; }
        const int nig = WGM * nN, gid = wgid / nig, fm = gid * WGM, gsz = (nM - fm) < WGM ? (nM - fm) : WGM;
        u.pm = fm + ((wgid % nig) % gsz); u.pn = (wgid % nig) / gsz; return true;
    }
    __device__ __forceinline__ void a_ready(const Unit&) const {}
    __device__ __forceinline__ void done(const Unit&) const {}
    __device__ __forceinline__ int nt_of(const Unit&) const { return ntf; }
    __device__ __forceinline__ int k0_of(const Unit&) const { return 0; }
};
struct TailOrder {
    StaticOrder full; int nMf, nMt, nN, G, c, KS, ntp, nfull;
    __host__ __device__ __forceinline__ void init(int Mfull, int M, int N, int K, int KS_, int G_, int c_) { full.init(Mfull, N, K, G_, c_); nMf = Mfull / BM; nMt = M / BM - nMf; nN = N / BM; G = G_; c = c_; KS = KS_; ntp = K / BK / KS_; nfull = nMf * nN; }
    __host__ __device__ __forceinline__ bool next(int i, Unit& u) const {
        const long L = (long)i * G + c;
        if (L < nfull) return full.next(i, u);
        const int j = (int)(L - nfull); if (j >= nMt * nN * KS) return false;
        const int tile = j / KS; u.pm = nMf + tile % nMt; u.pn = tile / nMt + 256 * (1 + j % KS); return true;
    }
    __device__ __forceinline__ void a_ready(const Unit&) const {}
    __device__ __forceinline__ void done(const Unit&) const {}
    __device__ __forceinline__ int nt_of(const Unit& u) const { return (u.pn >> 8) ? ntp : full.ntf; }
    __device__ __forceinline__ int k0_of(const Unit& u) const { const int p = u.pn >> 8; return p ? (p - 1) * ntp * BK : 0; }
};


__device__ __forceinline__ unsigned cvt_pk_bf16(float lo, float hi) { unsigned r; asm volatile("v_cvt_pk_bf16_f32 %0, %1, %2" : "=v"(r) : "v"(lo), "v"(hi)); return r; }
typedef float f32x2 __attribute__((ext_vector_type(2)));
__device__ __forceinline__ f32x2 gelu_pk(f32x2 v) {
    const f32x2 av = __builtin_elementwise_abs(v), d = av * 0.2316418882f + 1.0f;
    f32x2 t; t.x = __builtin_amdgcn_rcpf(d.x); t.y = __builtin_amdgcn_rcpf(d.y);
    f32x2 q = t * 0.5307027145f + (-0.7265760135f); q = q * t + 0.7107068705f; q = q * t + (-0.142248368f); q = q * t + 0.127414796f; q = q * t;
    const f32x2 s = (v * v) * (-0.72134752044f);
    f32x2 e; e.x = __builtin_amdgcn_exp2f(s.x); e.y = __builtin_amdgcn_exp2f(s.y);
    const f32x2 m = v * (q * e), r = v - m;
    f32x2 o; o.x = v.x < 0.f ? m.x : r.x; o.y = v.y < 0.f ? m.y : r.y; return o;
}

template <int ACT  > struct EpiBf16 {
    static constexpr bool PERM = true, AFTER_DRAIN = false; static_assert(ACT == 0 || ACT == 1, "EpiBf16: ACT is 0 (none) or 1 (gelu_pk)");
    bf16_t* O; int ldc; const float* bias; int split_cols; size_t split_stride; float scale0;
    __device__ __forceinline__ void operator()(const f32x4 (&acc)[2][2][4][2], const Unit& u, int wr, int wc, int fr, int fq) const {
        const int row0 = u.pm * BM + wr * 64 + fr; int colt = u.pn * BM; bf16_t* base = O;
        float sc = 1.f; if (split_cols) { const int t = colt / split_cols; base += (size_t)t * split_stride; colt -= t * split_cols; if (t == 0) sc = scale0; }
        const int col0 = colt + wc * 32 + 8 * fq, bcol0 = u.pn * BM + wc * 32 + 8 * fq;
        f32x4 bv[2][2];
#pragma unroll
        for (int bj = 0; bj < 2; ++bj)
#pragma unroll
            for (int n = 0; n < 2; ++n) bv[bj][n] = bias ? *(const f32x4*)(bias + bcol0 + bj * HALF + 4 * n) : (f32x4){0.f, 0.f, 0.f, 0.f};
#pragma unroll
        for (int ai = 0; ai < 2; ++ai)
#pragma unroll
            for (int m = 0; m < 4; ++m) { bf16_t* rowp = base + (size_t)(row0 + ai * HALF + m * 16) * ldc + col0;
#pragma unroll
                for (int bj = 0; bj < 2; ++bj) { f32x4 v0 = acc[ai][bj][m][0] + bv[bj][0], v1 = acc[ai][bj][m][1] + bv[bj][1];
                    if (ACT == 1) { f32x2 a = gelu_pk((f32x2){v0[0], v0[1]}), b = gelu_pk((f32x2){v0[2], v0[3]}), c = gelu_pk((f32x2){v1[0], v1[1]}), d = gelu_pk((f32x2){v1[2], v1[3]});
                        v0 = (f32x4){a.x, a.y, b.x, b.y}; v1 = (f32x4){c.x, c.y, d.x, d.y}; }
                    v0 = v0 * sc; v1 = v1 * sc; u32x4 w; w.x = cvt_pk_bf16(v0[0], v0[1]); w.y = cvt_pk_bf16(v0[2], v0[3]); w.z = cvt_pk_bf16(v1[0], v1[1]); w.w = cvt_pk_bf16(v1[2], v1[3]);
                    *(u32x4*)(rowp + bj * HALF) = w; } }
    }
};

template <class Epi, class Sched, bool ALIGN_EPI = false, bool SP2 = false>
__device__ __forceinline__ void gemm_phase(PG8_LAS unsigned char* lds, const Gemm g, const Sched& S, const Epi& E, const int wave_idx) {
    int tid_ = (int)__builtin_amdgcn_mbcnt_hi(~0u, __builtin_amdgcn_mbcnt_lo(~0u, 0u)); asm volatile("" : "+v"(tid_)); tid_ += 64 * wave_idx;
    const int tid = tid_, wid = __builtin_amdgcn_readfirstlane(tid >> 6), lane = tid & 63, wr = wid >> 2, wc = wid & 3, fr = lane & 15, fq = lane >> 4;
    const int K = g.K;
    unsigned voffA[2], voffB[2];
#pragma unroll
    for (int i = 0; i < 2; ++i) { int R, C; stage_rc(tid * 16 + i * 8192, R, C); const int Rb = Epi::PERM ? ((R & ~31) + perm32(R & 31)) : R;
        voffA[i] = (unsigned)(R * g.ld + C) * 2u; voffB[i] = (unsigned)(Rb * g.ld + C) * 2u; }
    const size_t kstep = (size_t)(BK * 2);
    const size_t hstep = (size_t)HALF * g.ld * 2;
    const size_t tstep = 2 * hstep;
    const unsigned ldsw = (unsigned)wid * 1024u;
    const int aoff = lds_byte(wr * 64 + fr, fq * 8), boff = lds_byte(wc * 32 + fr, fq * 8);
#define PG8_SA(b, h) (((b) * 2 + (h)) * HTB)
#define PG8_SB(b, h) ((4 + (b) * 2 + (h)) * HTB)
#define PG8_STAGE(bufoff, gbase, voff) do { _Pragma("unroll") for (int _i = 0; _i < 2; ++_i) \
        __builtin_amdgcn_global_load_lds((const unsigned*)((const char*)(gbase) + (voff)[_i]), (PG8_LAS unsigned*)(lds + (bufoff) + ldsw + _i * 8192), 16, 0, 0); } while (0)
#define PG8_LDA(dst, b, h) do { _Pragma("unroll") for (int m = 0; m < 4; ++m) _Pragma("unroll") for (int k = 0; k < 2; ++k) dst[m][k] = *(const PG8_LAS bf16x8*)(lds + PG8_SA(b, h) + aoff + m * 2048 + k * 1024); } while (0)
#define PG8_LDB(dst, b, h) do { _Pragma("unroll") for (int n = 0; n < 2; ++n) _Pragma("unroll") for (int k = 0; k < 2; ++k) dst[n][k] = *(const PG8_LAS bf16x8*)(lds + PG8_SB(b, h) + boff + n * 2048 + k * 1024); } while (0)
#define PG8_MMA(ai, bj, At, Bt) do { __builtin_amdgcn_s_setprio(1); _Pragma("unroll") for (int m = 0; m < 4; ++m) _Pragma("unroll") for (int n = 0; n < 2; ++n) _Pragma("unroll") for (int k = 0; k < 2; ++k) \
        acc[ai][bj][m][n] = __builtin_amdgcn_mfma_f32_16x16x32_bf16(Bt[n][k], At[m][k], acc[ai][bj][m][n], 0, 0, 0); __builtin_amdgcn_s_setprio(0); } while (0)
#define PG8_WAIT_V(n) asm volatile("s_waitcnt vmcnt(" #n ")" ::: "memory")
#define PG8_WAIT_L(n) asm volatile("s_waitcnt lgkmcnt(" #n ")" ::: "memory")
#define PG8_BAR __builtin_amdgcn_s_barrier()
#define PG8_SCHED __builtin_amdgcn_sched_barrier(0)
    Unit cur, nxt; int ui = 0;
    if (!S.next(0, cur)) return;
    f32x4 acc[2][2][4][2];
#pragma unroll
    for (int a = 0; a < 2; ++a)
#pragma unroll
        for (int b = 0; b < 2; ++b)
#pragma unroll
            for (int m = 0; m < 4; ++m)
#pragma unroll
                for (int n = 0; n < 2; ++n) acc[a][b][m][n] = (f32x4){0.f, 0.f, 0.f, 0.f};
    bf16x8 At[4][2], B0[2][2], B1[2][2];
    const char* cA = (const char*)g.A + (size_t)cur.pm * tstep + (size_t)S.k0_of(cur) * 2; const char* cB = (const char*)g.Bt + (size_t)unit_pn(cur) * tstep + (size_t)S.k0_of(cur) * 2;
    int nt = S.nt_of(cur);
    S.a_ready(cur);
    if constexpr (SP2) {
        PG8_STAGE(PG8_SB(0, 0), cB, voffB); PG8_STAGE(PG8_SB(0, 1), cB + hstep, voffB); PG8_STAGE(PG8_SA(0, 0), cA, voffA); PG8_STAGE(PG8_SA(0, 1), cA + hstep, voffA);
        if (wr == 1) PG8_BAR;
        PG8_WAIT_V(2); PG8_BAR;
        PG8_STAGE(PG8_SB(1, 0), cB + kstep, voffB); PG8_STAGE(PG8_SA(1, 0), cA + kstep, voffA); PG8_STAGE(PG8_SB(1, 1), cB + hstep + kstep, voffB);
        PG8_WAIT_V(6); PG8_BAR;
    } else {
        PG8_STAGE(PG8_SB(0, 0), cB, voffB); PG8_STAGE(PG8_SA(0, 0), cA, voffA); PG8_STAGE(PG8_SB(0, 1), cB + hstep, voffB); PG8_STAGE(PG8_SA(0, 1), cA + hstep, voffA);
        if (wr == 1) PG8_BAR;
        PG8_WAIT_V(4); PG8_BAR;
        PG8_STAGE(PG8_SB(1, 0), cB + kstep, voffB); PG8_STAGE(PG8_SA(1, 0), cA + kstep, voffA); PG8_STAGE(PG8_SB(1, 1), cB + hstep + kstep, voffB);
        PG8_WAIT_V(6); PG8_BAR;
    }
    for (;;) {
        const bool has_next = S.next(ui + 1, nxt);
        const char* nA = has_next ? (const char*)g.A + (size_t)nxt.pm * tstep + (size_t)S.k0_of(nxt) * 2 : cA; const char* nB = has_next ? (const char*)g.Bt + (size_t)unit_pn(nxt) * tstep + (size_t)S.k0_of(nxt) * 2 : cB;
        for (int t = 0; t < nt; t += 2) {
            const bool last = (t == nt - 2);
            const char* a1 = cA + (size_t)(t + 1) * kstep;
            const char* a2 = last ? nA : cA + (size_t)(t + 2) * kstep; const char* b2 = last ? nB : cB + (size_t)(t + 2) * kstep;
            const char* a3 = a2 + kstep; const char* b3 = b2 + kstep;
            if (last && has_next) S.a_ready(nxt);
            if constexpr (SP2) {
            PG8_LDB(B0, 0, 0); PG8_LDB(B1, 0, 1); PG8_SCHED; PG8_LDA(At, 0, 0); PG8_STAGE(PG8_SA(1, 1), a1 + hstep, voffA);
            PG8_WAIT_V(8); PG8_WAIT_L(0); PG8_BAR; PG8_MMA(0, 0, At, B0); PG8_MMA(0, 1, At, B1); PG8_BAR; PG8_SCHED;
            PG8_LDA(At, 0, 1); PG8_STAGE(PG8_SB(0, 0), b2, voffB); PG8_STAGE(PG8_SB(0, 1), b2 + hstep, voffB); PG8_STAGE(PG8_SA(0, 0), a2, voffA);
            PG8_WAIT_V(8); PG8_WAIT_L(0); PG8_BAR; PG8_MMA(1, 0, At, B0); PG8_MMA(1, 1, At, B1); PG8_BAR; PG8_SCHED;
            PG8_LDB(B0, 1, 0); PG8_LDB(B1, 1, 1); PG8_SCHED; PG8_LDA(At, 1, 0); PG8_STAGE(PG8_SA(0, 1), a2 + hstep, voffA);
            PG8_WAIT_V(8); PG8_WAIT_L(0); PG8_BAR; PG8_MMA(0, 0, At, B0); PG8_MMA(0, 1, At, B1); PG8_BAR; PG8_SCHED;
            PG8_LDA(At, 1, 1); PG8_STAGE(PG8_SB(1, 0), b3, voffB); PG8_STAGE(PG8_SB(1, 1), b3 + hstep, voffB); PG8_STAGE(PG8_SA(1, 0), a3, voffA);
            PG8_WAIT_V(8); PG8_WAIT_L(0); PG8_BAR; PG8_MMA(1, 0, At, B0); PG8_MMA(1, 1, At, B1); PG8_BAR; PG8_SCHED;
            } else {
            PG8_LDB(B0, 0, 0); PG8_SCHED; PG8_LDA(At, 0, 0); PG8_STAGE(PG8_SA(1, 1), a1 + hstep, voffA);
            PG8_WAIT_L(8); PG8_BAR; PG8_WAIT_L(0); PG8_MMA(0, 0, At, B0); PG8_BAR; PG8_SCHED;
            PG8_LDB(B1, 0, 1); PG8_STAGE(PG8_SB(0, 0), b2, voffB);
            PG8_BAR; PG8_WAIT_L(0); PG8_MMA(0, 1, At, B1); PG8_BAR;
            PG8_LDA(At, 0, 1); PG8_STAGE(PG8_SA(0, 0), a2, voffA);
            PG8_BAR; PG8_WAIT_L(0); PG8_MMA(1, 0, At, B0); PG8_BAR; PG8_SCHED;
            PG8_STAGE(PG8_SB(0, 1), b2 + hstep, voffB);
            PG8_WAIT_V(6); PG8_BAR; PG8_MMA(1, 1, At, B1); PG8_BAR;
            PG8_LDB(B0, 1, 0); PG8_SCHED; PG8_LDA(At, 1, 0); PG8_STAGE(PG8_SA(0, 1), a2 + hstep, voffA);
            PG8_WAIT_L(8); PG8_BAR; PG8_WAIT_L(0); PG8_MMA(0, 0, At, B0); PG8_BAR; PG8_SCHED;
            PG8_LDB(B1, 1, 1); PG8_STAGE(PG8_SB(1, 0), b3, voffB);
            PG8_BAR; PG8_WAIT_L(0); PG8_MMA(0, 1, At, B1); PG8_BAR;
            PG8_LDA(At, 1, 1); PG8_STAGE(PG8_SA(1, 0), a3, voffA);
            PG8_BAR; PG8_WAIT_L(0); PG8_MMA(1, 0, At, B0); PG8_BAR; PG8_SCHED;
            PG8_STAGE(PG8_SB(1, 1), b3 + hstep, voffB);
            PG8_WAIT_V(6); PG8_BAR; PG8_MMA(1, 1, At, B1); PG8_BAR;
            }
        }
        if constexpr (ALIGN_EPI) { if (wr == 0) PG8_BAR; }
        if constexpr (!Epi::AFTER_DRAIN) { E(acc, cur, wr, wc, fr, fq); S.done(cur); }
        if (!has_next) break;
#pragma unroll
        for (int a = 0; a < 2; ++a)
#pragma unroll
            for (int b = 0; b < 2; ++b)
#pragma unroll
                for (int m = 0; m < 4; ++m)
#pragma unroll
                    for (int n = 0; n < 2; ++n) acc[a][b][m][n] = (f32x4){0.f, 0.f, 0.f, 0.f};
        cur = nxt; cA = nA; cB = nB; ++ui; nt = S.nt_of(cur);
        if constexpr (ALIGN_EPI) { if (wr == 1) PG8_BAR; }
    }
    PG8_WAIT_V(0);
    if constexpr (!ALIGN_EPI) { if (wr == 0) PG8_BAR; }
    PG8_BAR;
    if constexpr (Epi::AFTER_DRAIN) { E.fused(acc, cur, wr, wc, fr, fq, lds, wid, lane); S.done(cur); }
#undef PG8_SA
#undef PG8_SB
#undef PG8_STAGE
#undef PG8_LDA
#undef PG8_LDB
#undef PG8_MMA
#undef PG8_WAIT_V
#undef PG8_WAIT_L
#undef PG8_BAR
#undef PG8_SCHED
}
}

#ifndef MK_N_LAUNCHES
#define MK_N_LAUNCHES 1
#endif
constexpr int NWAVES = 8;

constexpr int DM = 2048, NBATCH = 4, SEQ = 2048, NMETA = 16, DBATCH = 128, DSEQ = 8, PAST = 16384;
constexpr int NH = 8, DK = 256, DV = 512, RQK = 2048, RV = 4096, NRI = 2 * RQK + 2 * RV  , NCI = 4 * DM  ;
constexpr int ROW_S0 = NBATCH * SEQ  , ROW_M0 = ROW_S0 + DBATCH * DSEQ  , M_REAL = ROW_M0 + NMETA  , M_PAD = 9472  ;
constexpr int NPOS = NMETA + SEQ + DSEQ;
constexpr float LN_EPS = 1e-5f, GN_EPS = 1e-6f;
constexpr int LDP = 64, LD_X = DM + LDP  , LD_A2 = RV + LDP  , LD_PROJ = NRI + LDP  , LD_Y = RV + LDP  ;
constexpr float DN_ALPHA = 1.681792830507429f;
constexpr size_t O_YP = 0, O_YS = O_YP + (size_t)NBATCH * SEQ * DM, O_SRP = O_YS + (size_t)DBATCH * DSEQ * DM, O_SRS = O_SRP + (size_t)2 * NBATCH * NH * DK * DV,
                 O_SCP = O_SRS + (size_t)2 * DBATCH * NH * DK * DV, O_SCS = O_SCP + (size_t)2 * NBATCH * 2 * DM, O_END = O_SCS + (size_t)2 * DBATCH * 2 * DM;

constexpr size_t MiB = 1u << 20;
constexpr size_t WS_CTL = 0, CTL_ZERO_BYTES = 64 * 1024;
constexpr size_t WS_WRI = 2 * MiB;
constexpr size_t WS_WRO = WS_WRI + (size_t)2 * NRI * LD_X * 2;
constexpr size_t WS_WCI = WS_WRO + (size_t)2 * DM * LD_A2 * 2;
constexpr size_t WS_WCO = WS_WCI + (size_t)2 * NCI * LD_X * 2;
constexpr size_t WS_ROPE = WS_WCO + (size_t)2 * DM * LD_X * 2;
constexpr size_t WS_XF = WS_ROPE + 4 * MiB;
constexpr size_t WS_XB = WS_XF + (size_t)M_PAD * DM * 4;
constexpr size_t WS_PROJ = WS_XB + (size_t)M_PAD * LD_X * 2;
constexpr size_t WS_A2 = WS_PROJ + (size_t)M_PAD * LD_PROJ * 2;
constexpr size_t WS_H = WS_A2 + (size_t)M_PAD * LD_A2 * 2;
constexpr size_t WS_YF = WS_H + (size_t)M_PAD * DM * 4;
constexpr size_t WS_PART = WS_YF + (size_t)M_PAD * RV * 4;
constexpr int TAIL_KS = 4;
#ifndef MK_DEFER_CVT
#define MK_DEFER_CVT 1
#endif
constexpr int W_ALL = 0xFF, W_IN_PROLOGUE = MK_DEFER_CVT ? 0x03 : W_ALL;
constexpr size_t WS_END = WS_PART + (size_t)TAIL_KS * (M_PAD - ROW_S0) * DM * 4;
constexpr int CW_QUEUE = 1024;
constexpr int CW_BAR = 4096;

constexpr int RING_OFF = 0, RING_BYTES = 139264;
constexpr int LDSCTL_OFF = RING_BYTES, MISC_OFF = LDSCTL_OFF + 320;
constexpr int LDS_BYTES = 147456;

#define GAS __attribute__((address_space(1)))
#define LAS __attribute__((address_space(3)))
typedef unsigned short bf16;
typedef unsigned v4u __attribute__((ext_vector_type(4)));
typedef unsigned v2u __attribute__((ext_vector_type(2)));
typedef float f32x4 __attribute__((ext_vector_type(4)));
typedef GAS unsigned gu32;
#define RLX_AGENT __ATOMIC_RELAXED, __HIP_MEMORY_SCOPE_AGENT
#define LDS_WAIT() asm volatile("s_waitcnt lgkmcnt(0)" ::: "memory")
#define VM_WAIT() asm volatile("s_waitcnt vmcnt(0)" ::: "memory")
__device__ __forceinline__ unsigned f2bf(float f) { unsigned u = __builtin_bit_cast(unsigned, f); return (u + 0x7fffu + ((u >> 16) & 1u)) >> 16; }
__device__ __forceinline__ unsigned pk2(float lo, float hi) { return f2bf(lo) | (f2bf(hi) << 16); }
__device__ __forceinline__ float bf_lo(unsigned w) { return __builtin_bit_cast(float, w << 16); }
__device__ __forceinline__ float bf_hi(unsigned w) { return __builtin_bit_cast(float, w & 0xffff0000u); }
__device__ __forceinline__ float bf2f(bf16 b) { return __builtin_bit_cast(float, ((unsigned)b) << 16); }

#define XB_TMO      128
#define XB_XCNT(j)  (256  + 64 * (j))
#define XB_XSUB(j)  (1280 + 64 * (j))
#define XB_XGEN(j)  (2304 + 64 * (j))
#define XB_TOP      3328
#define XB_TOPGEN   3392
#define XCD_BAR_WORDS 3456
#define XB_SPIN_CAP (1u << 20)

__device__ __forceinline__ unsigned xb_ld(unsigned* p)              { return __hip_atomic_load(p, __ATOMIC_RELAXED, __HIP_MEMORY_SCOPE_AGENT); }
__device__ __forceinline__ unsigned xb_add(unsigned* p, unsigned v) { return __hip_atomic_fetch_add(p, v, __ATOMIC_RELAXED, __HIP_MEMORY_SCOPE_AGENT); }
__device__ __forceinline__ unsigned xb_xcc_id() { return (unsigned)__builtin_amdgcn_s_getreg((3 << 11) | 20) & 0xFu; }
#define XB_SPIN(cond, bar) do { unsigned _sp = 0; while (cond) { __builtin_amdgcn_s_sleep(1); \
    if ((++_sp & 255u) == 0u) { if (xb_ld(&(bar)[XB_TMO])) break; if (_sp > XB_SPIN_CAP) { atomicAdd(&(bar)[XB_TMO], 1u); break; } } } } while (0)

struct XcdBarrier { unsigned* bar; unsigned x; volatile LAS unsigned* st; };

__device__ __forceinline__ XcdBarrier xcd_barrier_post(unsigned* bar, volatile LAS unsigned* st) {
    XcdBarrier b; b.bar = bar; b.x = xb_xcc_id(); b.st = st;
    if (threadIdx.x == 0) (void)xb_add(&bar[XB_XCNT(b.x)], 1u);
    return b;
}
__device__ __forceinline__ void xcd_barrier_complete(unsigned* bar, unsigned x, unsigned& nloc, unsigned& nx) {
    const unsigned G = gridDim.x * gridDim.y * gridDim.z;
    unsigned sum, cnt, mine, sp = 0u;
    for (;;) {
        sum = 0u; cnt = 0u; mine = 0u;
#pragma unroll
        for (unsigned j = 0; j < 16; ++j) { const unsigned c = xb_ld(&bar[XB_XCNT(j)]); sum += c; cnt += (c > 0u) ? 1u : 0u; mine = (j == x) ? c : mine; }
        if (sum == G) break;
        __builtin_amdgcn_s_sleep(1);
        if ((++sp & 255u) == 0u) { if (xb_ld(&bar[XB_TMO])) break; if (sp > XB_SPIN_CAP) { atomicAdd(&bar[XB_TMO], 1u); break; } }
    }
    nloc = mine > 0u ? mine : 1u; nx = cnt > 0u ? cnt : 1u;
}
__device__ __forceinline__ void xcd_barrier(const XcdBarrier& b) {
    asm volatile("s_waitcnt vmcnt(0)" ::: "memory");
    __syncthreads();
    if (threadIdx.x == 0) {
        unsigned* bar = b.bar;
        __builtin_amdgcn_s_waitcnt(0);
        unsigned nloc = b.st[0], nx = b.st[1];
        if (nloc == 0u) { xcd_barrier_complete(bar, b.x, nloc, nx); b.st[0] = nloc; b.st[1] = nx; }
        const unsigned old = xb_add(&bar[XB_XSUB(b.x)], 1u);
        const unsigned gen = old / nloc;
        if (old + 1u == (gen + 1u) * nloc) {
            __builtin_amdgcn_fence(__ATOMIC_RELEASE, "agent");
            asm volatile("s_waitcnt vmcnt(0)" ::: "memory");
            const unsigned og = xb_add(&bar[XB_TOP], 1u);
            const unsigned tg = og / nx;
            if (og + 1u == (tg + 1u) * nx) xb_add(&bar[XB_TOPGEN], 1u);
            else XB_SPIN(xb_ld(&bar[XB_TOPGEN]) == tg, bar);
            __builtin_amdgcn_fence(__ATOMIC_ACQUIRE, "agent");
            xb_add(&bar[XB_XGEN(b.x)], 1u);
            asm volatile("s_waitcnt vmcnt(0)" ::: "memory");
        } else {
            XB_SPIN(xb_ld(&bar[XB_XGEN(b.x)]) == gen, bar);
            __builtin_amdgcn_fence(__ATOMIC_ACQUIRE, "agent");
            asm volatile("s_waitcnt vmcnt(0)" ::: "memory");
        }
    }
    __syncthreads();
}

struct Frame {
    LAS unsigned char* lds;
    volatile LAS unsigned* MISC;
    gu32* ctl;
    int tid, lane, wave, vcu, G;
    const float *x_prompt, *x_sample, *state_ret, *state_conv, *meta, *w_ret_in, *w_ret_out, *w_conv_in, *conv_w, *w_conv_out, *ln_g, *ln_b;
    float* out;
    bf16 *Wri, *Wro, *Wci, *Wco, *XB, *PROJ, *A2;
    float *YF, *ROPE, *PART; bf16 *YB, *HB, *QT;
};
__device__ __forceinline__ float wave_sum(float v) {
#pragma unroll
    for (int o = 1; o < 64; o <<= 1) v += __shfl_xor(v, o);
    return v;
}
__device__ __forceinline__ int row_pos_idx(int row) { return row < ROW_S0 ? (row & (SEQ - 1)) + NMETA : (row < ROW_M0 ? NMETA + SEQ + ((row - ROW_S0) & (DSEQ - 1)) : (row < M_REAL ? row - ROW_M0 : 0)); }

__host__ __device__ __forceinline__ int conv_col_perm(int n) { const int g = n >> 11, e = n & 2047, pn = e >> 6, el = e & 63; return 256 * pn + 128 * (g >> 1) + 32 * (el >> 4) + 8 * ((el >> 2) & 3) + 4 * (g & 1) + (el & 3); }
template <bool CPERM = false> __device__ __forceinline__ void p0_transpose_item(const float* W, int K, int N, bf16* WT, int ldw, LAS float* scr, int item, int lane) {
    const int nblk = N / 32, kb = item / nblk, nb = item % nblk, k0 = 64 * kb, n0 = 32 * nb;
#pragma unroll 8
    for (int i = 0; i < 32; ++i) { const int kk = 2 * i + (lane >> 5); scr[kk * 33 + (lane & 31)] = W[(size_t)(k0 + kk) * N + n0 + (lane & 31)]; }
    LDS_WAIT(); asm volatile("" ::: "memory");
    const int c = lane & 7;
#pragma unroll
    for (int j = 0; j < 4; ++j) { const int n = (lane >> 3) + 8 * j; const LAS float* s = scr + (8 * c) * 33 + n;
        v4u o; o.x = pk2(s[0 * 33], s[1 * 33]); o.y = pk2(s[2 * 33], s[3 * 33]); o.z = pk2(s[4 * 33], s[5 * 33]); o.w = pk2(s[6 * 33], s[7 * 33]);
        *(GAS v4u*)(WT + (size_t)(CPERM ? conv_col_perm(n0 + n) : n0 + n) * ldw + k0 + 8 * c) = o; }
    LDS_WAIT(); asm volatile("" ::: "memory");
}
__device__ __forceinline__ void sincos_d(float angf, float& s_out, float& c_out) {
    const double a = (double)angf;
    const double kq = rint(a * 0.63661977236758134308);
    double r = fma(-kq, 1.57079632679489655800e+00, a); r = fma(-kq, 6.12323399573676603587e-17, r);
    const double r2 = r * r;
    double sp = -7.6471637318198164759e-13; sp = fma(sp, r2, 1.6059043836821614599e-10); sp = fma(sp, r2, -2.5052108385441718775e-08); sp = fma(sp, r2, 2.7557319223985890653e-06);
    sp = fma(sp, r2, -1.9841269841269841270e-04); sp = fma(sp, r2, 8.3333333333333333333e-03); sp = fma(sp, r2, -1.6666666666666666667e-01); const double sn = fma(sp * r2, r, r);
    double cp = 4.7794773323873852974e-14; cp = fma(cp, r2, -1.1470745597729724714e-11); cp = fma(cp, r2, 2.0876756987868098979e-09); cp = fma(cp, r2, -2.7557319223985890653e-07);
    cp = fma(cp, r2, 2.4801587301587301587e-05); cp = fma(cp, r2, -1.3888888888888888889e-03); cp = fma(cp, r2, 4.1666666666666666667e-02); cp = fma(cp, r2, -0.5); const double cs = fma(cp, r2, 1.0);
    const int q = ((int)kq) & 3;
    const double S = (q == 0) ? sn : (q == 1) ? cs : (q == 2) ? -sn : -cs;
    const double C = (q == 0) ? cs : (q == 1) ? -sn : (q == 2) ? -cs : sn;
    s_out = (float)S; c_out = (float)C;
}

template <int MASK> __device__ __forceinline__ void convert_weights(Frame& F, int gw, int nw) {
    LAS float* scr = (LAS float*)(F.lds + RING_OFF + F.wave * 16384);
    constexpr int I_RI = (DM / 64) * (NRI / 32), I_RO = (RV / 64) * (DM / 32), I_CI = (DM / 64) * (NCI / 32), I_CO = (DM / 64) * (DM / 32);
    int lane = F.lane; asm volatile("" : "+v"(lane));
#pragma unroll
    for (int j = 0; j < 2; ++j) {
        if (MASK & (1 << (4 * j + 0))) for (int r = gw; r < I_RI; r += nw) p0_transpose_item(F.w_ret_in + (size_t)j * DM * NRI, DM, NRI, F.Wri + (size_t)j * NRI * LD_X, LD_X, scr, r, lane);
        if (MASK & (1 << (4 * j + 1))) for (int r = gw; r < I_RO; r += nw) p0_transpose_item(F.w_ret_out + (size_t)j * RV * DM, RV, DM, F.Wro + (size_t)j * DM * LD_A2, LD_A2, scr, r, lane);
        if (MASK & (1 << (4 * j + 2))) for (int r = gw; r < I_CI; r += nw) p0_transpose_item<true>(F.w_conv_in + (size_t)j * DM * NCI, DM, NCI, F.Wci + (size_t)j * NCI * LD_X, LD_X, scr, r, lane);
        if (MASK & (1 << (4 * j + 3))) for (int r = gw; r < I_CO; r += nw) p0_transpose_item(F.w_conv_out + (size_t)j * DM * DM, DM, DM, F.Wco + (size_t)j * DM * LD_X, LD_X, scr, r, lane);
    }
}
template <int MASK> __device__ __forceinline__ void convert_by_idle(Frame& F, int n_busy) {
    const int c = (int)blockIdx.x;
    if (MASK != 0 && c >= n_busy && F.G == 256) { F.lane = (int)__builtin_amdgcn_mbcnt_hi(~0u, __builtin_amdgcn_mbcnt_lo(~0u, 0u)); convert_weights<MASK>(F, (c - n_busy) * NWAVES + F.wave, (F.G - n_busy) * NWAVES); }
}
__device__ __forceinline__ void p0_prologue(Frame& F, const float* freq) {
    const int gw = F.vcu * NWAVES + F.wave, NGW = F.G * NWAVES;
    if (F.G == 256) convert_weights<W_IN_PROLOGUE>(F, gw, NGW); else convert_weights<W_ALL>(F, gw, NGW);
    for (int m = gw; m < M_PAD; m += NGW) {
        const float* src = m < ROW_S0 ? F.x_prompt + (size_t)m * DM : (m < ROW_M0 ? F.x_sample + (size_t)(m - ROW_S0) * DM : (m < M_REAL ? F.meta + (size_t)(m - ROW_M0) * DM : nullptr));
        v2u* xb = (v2u*)(F.XB + (size_t)m * LD_X) + F.lane;
#pragma unroll
        for (int j = 0; j < 8; ++j) { const f32x4 v = src ? ((const f32x4*)src)[F.lane + 64 * j] : (f32x4){0.f, 0.f, 0.f, 0.f}; v2u o; o.x = pk2(v.x, v.y); o.y = pk2(v.z, v.w); xb[64 * j] = o; }
    }
    const int gt = F.vcu * NWAVES * 64 + F.tid, NGT = F.G * NWAVES * 64;
    for (int i = gt; i < NPOS * 128; i += NGT) {
        const int p = i >> 7, d = i & 127; const int pos = p < NMETA + SEQ ? p : PAST + (p - (NMETA + SEQ));
        const float ang = (float)pos * freq[d]; float s, c; sincos_d(ang, s, c);
        F.ROPE[i] = c; F.ROPE[NPOS * 128 + i] = s;
    }
    if (gt < 128) { float s, c; sincos_d(16.0f * freq[gt], s, c); F.ROPE[2 * NPOS * 128 + gt] = c; F.ROPE[2 * NPOS * 128 + 128 + gt] = s; }
}

struct EpiResBf16 {
    static constexpr bool PERM = true, AFTER_DRAIN = false;
    bf16* C; const bf16* R; float* P; float alpha;
    __device__ __forceinline__ void operator()(const pg8::f32x4 (&acc)[2][2][4][2], const pg8::Unit& u, int wr, int wc, int fr, int fq) const {
        const int row0 = u.pm * pg8::BM + wr * 64 + fr, col0 = pg8::unit_pn(u) * pg8::BM + wc * 32 + 8 * fq, part = pg8::unit_part(u);
        if (part < 0) {
            v4u rr[2][4][2];
#pragma unroll
            for (int ai = 0; ai < 2; ++ai)
#pragma unroll
                for (int m = 0; m < 4; ++m)
#pragma unroll
                    for (int bj = 0; bj < 2; ++bj) rr[ai][m][bj] = *(const v4u*)(R + (size_t)(row0 + ai * pg8::HALF + m * 16) * LD_X + col0 + bj * pg8::HALF);
            asm volatile("" ::: "memory");
#pragma unroll
            for (int ai = 0; ai < 2; ++ai)
#pragma unroll
                for (int m = 0; m < 4; ++m) { const size_t off = (size_t)(row0 + ai * pg8::HALF + m * 16) * LD_X + col0;
#pragma unroll
                    for (int bj = 0; bj < 2; ++bj) { const v4u r = rr[ai][m][bj];
                        const pg8::f32x4 v0 = acc[ai][bj][m][0] + (pg8::f32x4){bf_lo(r.x), bf_hi(r.x), bf_lo(r.y), bf_hi(r.y)} * alpha, v1 = acc[ai][bj][m][1] + (pg8::f32x4){bf_lo(r.z), bf_hi(r.z), bf_lo(r.w), bf_hi(r.w)} * alpha;
                        pg8::u32x4 w; w.x = pg8::cvt_pk_bf16(v0[0], v0[1]); w.y = pg8::cvt_pk_bf16(v0[2], v0[3]); w.z = pg8::cvt_pk_bf16(v1[0], v1[1]); w.w = pg8::cvt_pk_bf16(v1[2], v1[3]);
                        *(pg8::u32x4*)(C + off + bj * pg8::HALF) = w; } }
        } else {
            bf16* Pp = (bf16*)P + (size_t)part * (M_PAD - ROW_S0) * DM;
#pragma unroll
            for (int ai = 0; ai < 2; ++ai)
#pragma unroll
                for (int m = 0; m < 4; ++m) { const size_t off = (size_t)(row0 - ROW_S0 + ai * pg8::HALF + m * 16) * DM + col0;
#pragma unroll
                    for (int bj = 0; bj < 2; ++bj) { const pg8::f32x4 v0 = acc[ai][bj][m][0], v1 = acc[ai][bj][m][1];
                        pg8::u32x4 w; w.x = pg8::cvt_pk_bf16(v0[0], v0[1]); w.y = pg8::cvt_pk_bf16(v0[2], v0[3]); w.z = pg8::cvt_pk_bf16(v1[0], v1[1]); w.w = pg8::cvt_pk_bf16(v1[2], v1[3]);
                        *(pg8::u32x4*)(Pp + off + bj * pg8::HALF) = w; } }
        }
    }
};

__device__ __forceinline__ f32x4 row_ror1(const f32x4 v) { f32x4 r;
#pragma unroll
    for (int j = 0; j < 4; ++j) { const float t = v[j]; r[j] = __int_as_float(__builtin_amdgcn_update_dpp(0, __float_as_int(t), 0x121, 0xf, 0xf, false)); }
    return r; }
__device__ __forceinline__ f32x4 row_ror2(const f32x4 v) { f32x4 r;
#pragma unroll
    for (int j = 0; j < 4; ++j) { const float t = v[j]; r[j] = __int_as_float(__builtin_amdgcn_update_dpp(0, __float_as_int(t), 0x122, 0xf, 0xf, false)); }
    return r; }
struct EpiConvGate {
    static constexpr bool PERM = true, AFTER_DRAIN = false;
    bf16* O; float* sp; float* ss;
    bf16* A; const float* cw; LAS float* xl;
    __device__ __forceinline__ void operator()(const pg8::f32x4 (&acc)[2][2][4][2], const pg8::Unit& u, int wr, int wc, int fr, int fq) const {
        const int row0 = u.pm * pg8::BM + wr * 64 + fr, e0 = 64 * u.pn + 16 * wc + 4 * fq;
        if (u.pm < ROW_S0 / pg8::BM) {
            const pg8::f32x4 w0 = *(const pg8::f32x4*)(cw + e0), w1 = *(const pg8::f32x4*)(cw + DM + e0), w2 = *(const pg8::f32x4*)(cw + 2 * DM + e0);
            pg8::f32x4 uu[2][4];
#pragma unroll
            for (int ai = 0; ai < 2; ++ai)
#pragma unroll
                for (int m = 0; m < 4; ++m) uu[ai][m] = acc[ai][0][m][1] * acc[ai][1][m][0];
            if (fr >= 14) {
#pragma unroll
                for (int ai = 0; ai < 2; ++ai) *(LAS pg8::f32x4*)(xl + (size_t)(((((wr * 4 + wc) * 2 + ai) * 2 + (fr - 14)) * 4 + fq) * 4)) = uu[ai][3];
            }
            { const int t = (row0 + pg8::HALF + 48) & (SEQ - 1);
              if (t >= SEQ - 2) *(pg8::f32x4*)(sp + ((size_t)((row0 + pg8::HALF + 48) >> 11) * 2 + (t - (SEQ - 2))) * DM + e0) = uu[1][3]; }
            LDS_WAIT(); __builtin_amdgcn_s_barrier(); asm volatile("" ::: "memory");
#pragma unroll
            for (int ai = 0; ai < 2; ++ai) {
                const int B = 2 * ai + wr;
                pg8::f32x4 P = {0.f, 0.f, 0.f, 0.f};
                if (B > 0 && fr >= 14) P = *(const LAS pg8::f32x4*)(xl + (size_t)((((((1 - wr) * 4 + wc) * 2 + (wr ? ai : ai - 1)) * 2 + (fr - 14)) * 4 + fq) * 4));
#pragma unroll
                for (int m = 0; m < 4; ++m) { const int row = row0 + ai * pg8::HALF + m * 16;
                    const pg8::f32x4 U = uu[ai][m], Pm = m == 0 ? P : uu[ai][m - 1];
                    const pg8::f32x4 a1 = row_ror1(U), b1 = row_ror1(Pm), a2 = row_ror2(U), b2 = row_ror2(Pm);
                    const pg8::f32x4 u1 = fr >= 1 ? a1 : b1, u2 = fr >= 2 ? a2 : b2;
                    const pg8::f32x4 b = acc[ai][0][m][0], z = acc[ai][1][m][1]; pg8::f32x4 g2, r;
#pragma unroll
                    for (int j = 0; j < 4; ++j) { g2[j] = z[j] * __builtin_amdgcn_rcpf(1.0f + __expf(-z[j])) * b[j]; r[j] = g2[j] * (w0[j] * u2[j] + w1[j] * u1[j] + w2[j] * U[j]); }
                    v2u w; w.x = pg8::cvt_pk_bf16(r[0], r[1]); w.y = pg8::cvt_pk_bf16(r[2], r[3]); *(v2u*)(A + (size_t)row * LD_X + e0) = w;
                    if ((B == 0 && m == 0 && fr < 2) || (B == 3 && m == 3 && fr >= 14)) { bf16* rp = O + (size_t)row * LD_PROJ + e0;
                        w.x = pg8::cvt_pk_bf16(U[0], U[1]); w.y = pg8::cvt_pk_bf16(U[2], U[3]); *(v2u*)rp = w;
                        w.x = pg8::cvt_pk_bf16(g2[0], g2[1]); w.y = pg8::cvt_pk_bf16(g2[2], g2[3]); *(v2u*)(rp + DM) = w; }
                }
            }
            return;
        }
#pragma unroll
        for (int ai = 0; ai < 2; ++ai)
#pragma unroll
            for (int m = 0; m < 4; ++m) { const int row = row0 + ai * pg8::HALF + m * 16;
                const pg8::f32x4 b = acc[ai][0][m][0], c = acc[ai][0][m][1], v = acc[ai][1][m][0], z = acc[ai][1][m][1];
                const pg8::f32x4 uu = c * v; pg8::f32x4 g2;
#pragma unroll
                for (int j = 0; j < 4; ++j) g2[j] = z[j] * __builtin_amdgcn_rcpf(1.0f + __expf(-z[j])) * b[j];
                bf16* rp = O + (size_t)row * LD_PROJ + e0;
                v2u w; w.x = pg8::cvt_pk_bf16(uu[0], uu[1]); w.y = pg8::cvt_pk_bf16(uu[2], uu[3]); *(v2u*)rp = w;
                w.x = pg8::cvt_pk_bf16(g2[0], g2[1]); w.y = pg8::cvt_pk_bf16(g2[2], g2[3]); *(v2u*)(rp + DM) = w;
                if (row >= ROW_S0 && row < ROW_M0) { const int s = (row - ROW_S0) & (DSEQ - 1); if (s >= DSEQ - 2) *(pg8::f32x4*)(ss + ((size_t)((row - ROW_S0) >> 3) * 2 + (s - (DSEQ - 2))) * DM + e0) = uu; }
            }
    }
};

struct EpiRopeBf16 {
    static constexpr bool PERM = true, AFTER_DRAIN = false;
    pg8::bf16_t* O; int ldc; const float* rope; pg8::bf16_t* QT;
    __device__ __forceinline__ void operator()(const pg8::f32x4 (&acc)[2][2][4][2], const pg8::Unit& u, int wr, int wc, int fr, int fq) const {
        const int row0 = u.pm * pg8::BM + wr * 64 + fr, col0 = u.pn * pg8::BM + wc * 32 + 8 * fq;
        if (u.pn < 16) {
            const bool isq = u.pn < 8; const int d0 = wc * 32 + 8 * fq;
            const float lgh = log2f(1.0f - exp2f(-5.0f - (float)(u.pn & 7)));
            const bool prow = u.pm < ROW_S0 / pg8::BM;
            pg8::f32x4 C0 = {1.f, 1.f, 1.f, 1.f}, C1 = C0, S0 = {0.f, 0.f, 0.f, 0.f}, S1 = S0;
            if (prow) { const float* stp = rope + (size_t)2 * NPOS * 128 + d0; C0 = *(const pg8::f32x4*)stp; C1 = *(const pg8::f32x4*)(stp + 4); S0 = *(const pg8::f32x4*)(stp + 128); S1 = *(const pg8::f32x4*)(stp + 132); }
            pg8::f32x4 cb0[2], cb1[2], sb0[2], sb1[2];
#pragma unroll
            for (int ai = 0; ai < 2; ++ai) { const float* ct = rope + (size_t)row_pos_idx(row0 + ai * pg8::HALF) * 128 + d0; const float* st = ct + (size_t)NPOS * 128;
                cb0[ai] = *(const pg8::f32x4*)ct; cb1[ai] = *(const pg8::f32x4*)(ct + 4); sb0[ai] = *(const pg8::f32x4*)st; sb1[ai] = *(const pg8::f32x4*)(st + 4); }
#pragma unroll
            for (int ai = 0; ai < 2; ++ai) {
                pg8::f32x4 rc0 = cb0[ai], rc1 = cb1[ai], rs0 = sb0[ai], rs1 = sb1[ai];
#pragma unroll
                for (int m = 0; m < 4; ++m) { const int row = row0 + ai * pg8::HALF + m * 16;
                    if (m > 0) { const pg8::f32x4 t0 = rc0 * C0 - rs0 * S0, t1 = rc1 * C1 - rs1 * S1; rs0 = rs0 * C0 + rc0 * S0; rs1 = rs1 * C1 + rc1 * S1; rc0 = t0; rc1 = t1; }
                    const int ci = row < ROW_S0 ? (row & 127) : (row >= ROW_M0 && row < M_REAL ? 112 + (row - ROW_M0) : 0);
                    const float sc = isq ? 0.0625f * __builtin_amdgcn_exp2f(lgh * (float)ci) : __builtin_amdgcn_exp2f(-lgh * (float)ci);
                    const pg8::f32x4 c0 = rc0 * sc, c1 = rc1 * sc, s0 = rs0 * sc, s1 = rs1 * sc;
                    const pg8::f32x4 a0 = acc[ai][0][m][0], a1 = acc[ai][0][m][1], b0 = acc[ai][1][m][0], b1 = acc[ai][1][m][1];
                    const pg8::f32x4 x0 = a0 * c0 - b0 * s0, x1 = a1 * c1 - b1 * s1, y0 = a0 * s0 + b0 * c0, y1 = a1 * s1 + b1 * c1;
                    const bool toqt = isq && (row < ROW_S0 || row >= ROW_M0);
                    const int ci2 = row < ROW_S0 ? (row & 127) : 112 + (row - ROW_M0);
                    const size_t blk = row < ROW_S0 ? (size_t)(((row >> 11) * NH + (u.pn & 7)) * 16 + ((row & 2047) >> 7)) * 4 + (ci2 >> 5) : (size_t)NBATCH * NH * 16 * 4 + (row < M_REAL ? 0 : NH) + (u.pn & 7);
                    pg8::bf16_t* qb = QT + blk * 8192 + ((size_t)((2 * wc + (fq >> 1)) * 64 + (fq & 1) * 32 + (ci2 & 31))) * 8;
                    pg8::bf16_t* pp = O + (size_t)row * ldc + col0;
                    pg8::bf16_t* p1 = toqt ? qb : pp; pg8::bf16_t* p2 = toqt ? qb + 8 * 64 * 8 : pp + pg8::HALF;
                    pg8::u32x4 w; w.x = pg8::cvt_pk_bf16(x0[0], x0[1]); w.y = pg8::cvt_pk_bf16(x0[2], x0[3]); w.z = pg8::cvt_pk_bf16(x1[0], x1[1]); w.w = pg8::cvt_pk_bf16(x1[2], x1[3]);
                    *(pg8::u32x4*)p1 = w;
                    w.x = pg8::cvt_pk_bf16(y0[0], y0[1]); w.y = pg8::cvt_pk_bf16(y0[2], y0[3]); w.z = pg8::cvt_pk_bf16(y1[0], y1[1]); w.w = pg8::cvt_pk_bf16(y1[2], y1[3]);
                    *(pg8::u32x4*)p2 = w; }
            }
        } else {
#pragma unroll
            for (int ai = 0; ai < 2; ++ai)
#pragma unroll
                for (int m = 0; m < 4; ++m) { pg8::bf16_t* rowp = O + (size_t)(row0 + ai * pg8::HALF + m * 16) * ldc + col0;
#pragma unroll
                    for (int bj = 0; bj < 2; ++bj) { const pg8::f32x4 v0 = acc[ai][bj][m][0], v1 = acc[ai][bj][m][1];
                        pg8::u32x4 w; w.x = pg8::cvt_pk_bf16(v0[0], v0[1]); w.y = pg8::cvt_pk_bf16(v0[2], v0[3]); w.z = pg8::cvt_pk_bf16(v1[0], v1[1]); w.w = pg8::cvt_pk_bf16(v1[2], v1[3]);
                        *(pg8::u32x4*)(rowp + bj * pg8::HALF) = w; } }
        }
    }
};

typedef float f32x2 __attribute__((ext_vector_type(2)));
struct SamplePre { v4u qk, v, g; };
__device__ __forceinline__ void sample_prefetch(Frame& F, int b, int h, SamplePre& p) {
    const int l = F.tid >> 6, c8 = F.tid & 63; const bf16* pr = F.PROJ + (size_t)(ROW_S0 + b * DSEQ + l) * LD_PROJ;
    p.qk = *(const v4u*)(pr + (c8 < 32 ? 0 : RQK) + h * DK + (c8 & 31) * 8);
    p.v = *(const v4u*)(pr + 2 * RQK + h * DV + c8 * 8);
    p.g = *(const v4u*)(pr + 2 * RQK + RV + h * DV + c8 * 8);
}
template <int VAR = 0, int PF = 8> __device__ __forceinline__ void retention_sample_unit(Frame& F, int lj, int b, int h, const SamplePre& pre) {
    LAS float* kq = (LAS float*)(F.lds + RING_OFF);
    LAS float* vl = (LAS float*)(F.lds + RING_OFF + 16384);
    LAS float* op = (LAS float*)(F.lds + RING_OFF + 32768);
    LAS float* Am = (LAS float*)(F.lds + RING_OFF + 98304);
    const float lg = log2f(1.0f - exp2f(-5.0f - (float)h));
    const int row0 = ROW_S0 + b * DSEQ;
    {
        const int l = F.tid >> 6, c8 = F.tid & 63; const bool isq = c8 < 32; const int d0 = (c8 & 31) * 8;
        const v4u w = pre.qk;
        const float sc = exp2f(lg * (isq ? (float)(l + 1) : (float)(7 - l)));
        const float e[8] = {bf_lo(w.x), bf_hi(w.x), bf_lo(w.y), bf_hi(w.y), bf_lo(w.z), bf_hi(w.z), bf_lo(w.w), bf_hi(w.w)};
#pragma unroll
        for (int j = 0; j < 8; ++j) kq[(d0 + j) * 16 + (isq ? 8 + l : l)] = e[j] * sc;
        const v4u wv = pre.v;
        LAS float* vd = vl + l * 512 + c8 * 8;
        vd[0] = bf_lo(wv.x); vd[1] = bf_hi(wv.x); vd[2] = bf_lo(wv.y); vd[3] = bf_hi(wv.y); vd[4] = bf_lo(wv.z); vd[5] = bf_hi(wv.z); vd[6] = bf_lo(wv.w); vd[7] = bf_hi(wv.w);
    }
    __syncthreads();
    {
        const int p = F.tid >> 3, part = F.tid & 7, l = p >> 3, m = p & 7; float a = 0.f;
        for (int d = part * 32; d < part * 32 + 32; ++d) a += kq[d * 16 + 8 + l] * kq[d * 16 + m];
        a += __shfl_xor(a, 1); a += __shfl_xor(a, 2); a += __shfl_xor(a, 4);
        if (part == 0) Am[p] = m <= l ? a * exp2f(-8.0f * lg) : 0.f;
    }
    const int rg = F.wave >> 1, vq = F.tid & 127;
    const float g8 = exp2f(8.0f * lg);
    f32x4 vv[8], o[8];
#pragma unroll
    for (int l = 0; l < 8; ++l) { vv[l] = *(const LAS f32x4*)(vl + l * 512 + 4 * vq); o[l] = (f32x4){0.f, 0.f, 0.f, 0.f}; }
    const size_t sbase = ((size_t)(lj * DBATCH + b) * NH + h) * DK * DV + (size_t)(rg * 64) * DV + 4 * vq;
    const f32x4* sp = (const f32x4*)(F.state_ret + sbase); f32x4* so = (f32x4*)(F.out + O_SRS + sbase);
    f32x4 buf[PF];
#pragma unroll
    for (int u = 0; u < PF; ++u) buf[u] = __builtin_nontemporal_load(sp + (size_t)u * (DV / 4));
    for (int i0 = 0; i0 < 64; i0 += PF) {
#pragma unroll
        for (int u = 0; u < PF; ++u) {
            const f32x4 s = buf[u];
            if (i0 + PF < 64) buf[u] = __builtin_nontemporal_load(sp + (size_t)(i0 + PF + u) * (DV / 4));
            if (VAR == 1) { o[0] += s; __builtin_nontemporal_store(s * g8, so + (size_t)(i0 + u) * (DV / 4)); continue; }
            if (VAR == 2) { o[0] += s; continue; }
            const LAS f32x4* kr = (const LAS f32x4*)(kq + (rg * 64 + i0 + u) * 16);
            const f32x4 k03 = kr[0], k47 = kr[1], q03 = kr[2], q47 = kr[3];
            o[0] += s * q03.x; o[1] += s * q03.y; o[2] += s * q03.z; o[3] += s * q03.w; o[4] += s * q47.x; o[5] += s * q47.y; o[6] += s * q47.z; o[7] += s * q47.w;
            f32x4 sn = s * g8;
            sn += vv[0] * k03.x; sn += vv[1] * k03.y; sn += vv[2] * k03.z; sn += vv[3] * k03.w; sn += vv[4] * k47.x; sn += vv[5] * k47.y; sn += vv[6] * k47.z; sn += vv[7] * k47.w;
            __builtin_nontemporal_store(sn, so + (size_t)(i0 + u) * (DV / 4));
        }
    }
#pragma unroll
    for (int l = 0; l < 8; ++l) *(LAS f32x4*)(op + (rg * 8 + l) * 512 + 4 * vq) = o[l];
    __syncthreads();
    {
        const int l = F.wave, v0 = 8 * F.lane; float y[8];
#pragma unroll
        for (int j = 0; j < 8; ++j) y[j] = 0.f;
#pragma unroll
        for (int r = 0; r < 4; ++r) { const f32x4 a = *(const LAS f32x4*)(op + (r * 8 + l) * 512 + v0), c = *(const LAS f32x4*)(op + (r * 8 + l) * 512 + v0 + 4);
            y[0] += a.x; y[1] += a.y; y[2] += a.z; y[3] += a.w; y[4] += c.x; y[5] += c.y; y[6] += c.z; y[7] += c.w; }
        for (int m = 0; m <= l; ++m) { const float am = Am[l * 8 + m]; const f32x4 a = *(const LAS f32x4*)(vl + m * 512 + v0), c = *(const LAS f32x4*)(vl + m * 512 + v0 + 4);
            y[0] += am * a.x; y[1] += am * a.y; y[2] += am * a.z; y[3] += am * a.w; y[4] += am * c.x; y[5] += am * c.y; y[6] += am * c.z; y[7] += am * c.w; }
        float s1 = 0.f;
#pragma unroll
        for (int j = 0; j < 8; ++j) s1 += y[j];
        const float mu = wave_sum(s1) * (1.f / DV); float s2 = 0.f;
#pragma unroll
        for (int j = 0; j < 8; ++j) { y[j] -= mu; s2 += y[j] * y[j]; }
        const float rs = 1.0f / sqrtf(wave_sum(s2) * (1.f / DV) + GN_EPS);
        const v4u gw4 = pre.g;
        const float g[8] = {bf_lo(gw4.x), bf_hi(gw4.x), bf_lo(gw4.y), bf_hi(gw4.y), bf_lo(gw4.z), bf_hi(gw4.z), bf_lo(gw4.w), bf_hi(gw4.w)};
        float r[8];
#pragma unroll
        for (int j = 0; j < 8; ++j) r[j] = g[j] / (1.0f + __expf(-g[j])) * (y[j] * rs);
        v4u w; w.x = pk2(r[0], r[1]); w.y = pk2(r[2], r[3]); w.z = pk2(r[4], r[5]); w.w = pk2(r[6], r[7]);
        *(v4u*)(F.A2 + (size_t)(row0 + l) * LD_A2 + h * DV + v0) = w;
    }
    __syncthreads();
}
typedef float f32x16 __attribute__((ext_vector_type(16)));
typedef short s16x8 __attribute__((ext_vector_type(8)));
typedef short s16x4 __attribute__((ext_vector_type(4)));
typedef short v4i16_t __attribute__((ext_vector_type(4)));
typedef __bf16 bf16x2_t __attribute__((ext_vector_type(2)));
__device__ __forceinline__ unsigned cvtpk(float lo, float hi) { const f32x2 v = {lo, hi}; return __builtin_bit_cast(unsigned, __builtin_convertvector(v, bf16x2_t)); }
__device__ __forceinline__ int crow(int r, int hk) { return (r & 3) + 8 * (r >> 2) + 4 * hk; }
__device__ __forceinline__ unsigned off_b(unsigned row, unsigned ch) { return 256u * row + 16u * (ch ^ (((row & 3u) << 2) | ((row >> 2) & 3u))); }
__device__ __forceinline__ unsigned offv(unsigned m, unsigned ch) { return 128u * m + 16u * (ch ^ (((m >> 1) & 1u) << 2)); }
__device__ __forceinline__ s16x4 tr_read(LAS unsigned char* p) { return __builtin_bit_cast(s16x4, __builtin_amdgcn_ds_read_tr16_b64_v4i16((LAS v4i16_t*)p)); }
__device__ __forceinline__ int tok_row(int c, int i, int b) { const int t = 128 * c + i - 112; return t < 0 ? -1 : (t < NMETA ? ROW_M0 + t : b * SEQ + (t - NMETA)); }
#define MFMA32(a, b, c) __builtin_amdgcn_mfma_f32_32x32x16_bf16((a), (b), (c), 0, 0, 0)
#define RP_LANES() int lane_ = (int)__builtin_amdgcn_mbcnt_hi(~0u, __builtin_amdgcn_mbcnt_lo(~0u, 0u)); asm volatile("" : "+v"(lane_)); const int lr = lane_ & 31, hk = lane_ >> 5, blk = (lane_ >> 4) & 1, q4 = (lane_ & 15) >> 2, p4 = lane_ & 3; const unsigned trsub = 8u * (p4 & 1); (void)lr; (void)hk; (void)blk; (void)q4; (void)trsub
#define RP_TID() int tid_ = (int)__builtin_amdgcn_mbcnt_hi(~0u, __builtin_amdgcn_mbcnt_lo(~0u, 0u)); asm volatile("" : "+v"(tid_)); tid_ += 64 * w
#define RP_SB() __builtin_amdgcn_sched_barrier(0)
__device__ __forceinline__ void rp_dma_kv(LAS unsigned char* KI, LAS unsigned char* VI, const bf16* Pk, const bf16* Pv, const void* zero16, int cc, int b, int w, int lane) {
#pragma unroll
    for (int i = 0; i < 8; ++i) { const int piece = w * 8 + i;
        const int dh = piece >> 5, r = 4 * (piece & 31) + (lane >> 4), pc = lane & 15, ch = pc ^ (((r & 3) << 2) | ((r >> 2) & 3));
        const int row = tok_row(cc, r, b);
        const void* g = row >= 0 ? (const void*)(Pk + (size_t)row * LD_PROJ + dh * 128 + 8 * ch) : zero16;
        __builtin_amdgcn_global_load_lds((const unsigned*)g, (LAS unsigned*)(KI + piece * 1024), 16, 0, 0); }
#pragma unroll
    for (int i = 0; i < 2; ++i) { const int piece = w * 2 + i;
        const int m = 8 * piece + (lane >> 3), pc = lane & 7, ch = pc ^ (((m >> 1) & 1) << 2);
        const int row = tok_row(cc, m, b);
        const void* g = row >= 0 ? (const void*)(Pv + (size_t)row * LD_PROJ + 8 * ch) : zero16;
        __builtin_amdgcn_global_load_lds((const unsigned*)g, (LAS unsigned*)(VI + piece * 1024), 16, 0, 0); }
}
template <int SKIP = 0> __device__ __forceinline__ void retention_prompt_mfma_unit(Frame& F, int lj, int uu) {
    LAS unsigned char* KI = F.lds + RING_OFF;
    LAS unsigned char* VI = F.lds + RING_OFF + 65536;
    LAS unsigned char* SI = F.lds + RING_OFF + 81920;
    LAS unsigned char* OT = F.lds + RING_OFF + 114688;
    const int vs = uu & 7, h = (uu >> 3) & 7, b = uu >> 6;
    const int w = F.wave;
    const int lb = w < 4 ? (w >> 1) : 3 - ((w - 4) >> 1), vb = w & 1;
    const float lg = log2f(1.0f - exp2f(-5.0f - (float)h));
    const bf16* Pk = F.PROJ + RQK + h * DK; const bf16* Pv = F.PROJ + 2 * RQK + h * DV + 64 * vs;
    { RP_TID(); for (int i = tid_; i < 32768 / 16; i += NWAVES * 64) *(LAS v4u*)(SI + 16 * i) = (v4u){0u, 0u, 0u, 0u}; }
    f32x16 Sacc[2];
#pragma unroll
    for (int r = 0; r < 16; ++r) { Sacc[0][r] = 0.f; Sacc[1][r] = 0.f; }
    s16x8 Qf[16], Qn[8];
    const void* zero16 = (const void*)((const unsigned char*)F.ctl + 8192);
    { RP_TID(); RP_LANES(); (void)tid_;
      rp_dma_kv(KI, VI, Pk, Pv, zero16, 0, b, w, lane_);
      { const bf16* q0 = F.QT + ((size_t)NBATCH * NH * 16 * 4 + h) * 8192 + lane_ * 8; const bool qv = lb == 3 && lr >= 16;
#pragma unroll
        for (int s = 0; s < 16; ++s) Qf[s] = qv ? *(const s16x8*)(q0 + s * 512) : (s16x8){0, 0, 0, 0, 0, 0, 0, 0}; }
    }
    asm volatile("s_waitcnt vmcnt(0)" ::: "memory");
    __syncthreads();
    for (int c = 0; c < 17; ++c) {
        if (c < 16 && !(SKIP & 8)) { RP_LANES();
          { const bf16* qn = F.QT + ((size_t)(((b * NH + h) * 16 + c) * 4 + lb)) * 8192 + lane_ * 8;
#pragma unroll
            for (int s = 0; s < 8; ++s) Qn[s] = *(const s16x8*)(qn + s * 512); }
        }
        RP_SB();
        f32x16 Oacc;
#pragma unroll
        for (int r = 0; r < 16; ++r) Oacc[r] = 0.f;
        for (int mb = 0; mb <= ((SKIP & 1) ? -1 : lb); ++mb) { RP_LANES();
            f32x16 Sc;
#pragma unroll
            for (int r = 0; r < 16; ++r) Sc[r] = 0.f;
            LAS unsigned char* krow = KI + 256 * (32 * mb + lr); const unsigned xr = ((lr & 3) << 2) | ((lr >> 2) & 3);
#pragma unroll
            for (int s = 0; s < 16; ++s) { const s16x8 a = *(const LAS s16x8*)(krow + (s >> 3) * 32768 + 16 * ((2 * (s & 7) + hk) ^ xr)); Sc = MFMA32(a, Qf[s], Sc); }
            if (mb == lb) {
#pragma unroll
                for (int r = 0; r < 16; ++r) Sc[r] = lr >= crow(r, hk) ? Sc[r] : 0.f;
            }
#pragma unroll
            for (int s2 = 0; s2 < 2; ++s2) {
                v4u pw; pw.x = cvtpk(Sc[8 * s2 + 0], Sc[8 * s2 + 1]); pw.y = cvtpk(Sc[8 * s2 + 2], Sc[8 * s2 + 3]); pw.z = cvtpk(Sc[8 * s2 + 4], Sc[8 * s2 + 5]); pw.w = cvtpk(Sc[8 * s2 + 6], Sc[8 * s2 + 7]);
                const s16x8 Pf = __builtin_bit_cast(s16x8, pw);
                const unsigned m0 = 32 * mb + 16 * s2 + 4 * hk + q4, chv = 4 * vb + 2 * blk + (p4 >> 1);
                const s16x4 lo = tr_read(VI + offv(m0, chv) + trsub), hi = tr_read(VI + offv(m0 + 8, chv) + trsub);
                const s16x8 Va = __builtin_shufflevector(lo, hi, 0, 1, 2, 3, 4, 5, 6, 7);
                Oacc = MFMA32(Va, Pf, Oacc);
            }
        }
        RP_SB();
        { RP_LANES();
            LAS unsigned char* kbase = KI + (w >> 2) * 32768 + trsub; const unsigned chk = 4 * (w & 3) + 2 * blk + (p4 >> 1);
            LAS unsigned char* vbase = VI + trsub; const unsigned chv = 2 * blk + (p4 >> 1);
#pragma unroll
            for (int s = 0; s < ((SKIP & 4) ? 0 : 8); ++s) {
                const unsigned mrow = 16 * s + 8 * hk + q4;
                const s16x4 k0 = tr_read(kbase + off_b(mrow, chk)), k1 = tr_read(kbase + off_b(mrow + 4, chk));
                const s16x8 Ka = __builtin_shufflevector(k0, k1, 0, 1, 2, 3, 4, 5, 6, 7);
#pragma unroll
                for (int v2 = 0; v2 < 2; ++v2) {
                    const s16x4 v0 = tr_read(vbase + offv(mrow, 4 * v2 + chv)), v1 = tr_read(vbase + offv(mrow + 4, 4 * v2 + chv));
                    const s16x8 Vb = __builtin_shufflevector(v0, v1, 0, 1, 2, 3, 4, 5, 6, 7);
                    Sacc[v2] = MFMA32(Ka, Vb, Sacc[v2]);
                }
            }
        }
        RP_SB();
        __syncthreads();
        if (c < 16 && !(SKIP & 16)) { RP_LANES(); rp_dma_kv(KI, VI, Pk, Pv, zero16, c + 1, b, w, lane_); }
        { RP_LANES();
            LAS unsigned char* srow = SI + 256 * (32 * vb + lr); const unsigned xr = ((lr & 3) << 2) | ((lr >> 2) & 3);
            if (!(SKIP & 2)) {
#pragma unroll
            for (int s = 0; s < 16; ++s) { const s16x8 a = *(const LAS s16x8*)(srow + (s >> 3) * 16384 + 16 * ((2 * (s & 7) + hk) ^ xr)); Oacc = MFMA32(a, Qf[s], Oacc); }
            }
          { LAS unsigned char* op = OT + 144 * (32 * lb + lr) + 2 * (32 * vb + 4 * hk);
#pragma unroll
            for (int g4 = 0; g4 < 4; ++g4) { v2u o; o.x = cvtpk(Oacc[4 * g4], Oacc[4 * g4 + 1]); o.y = cvtpk(Oacc[4 * g4 + 2], Oacc[4 * g4 + 3]); *(LAS v2u*)(op + 16 * g4) = o; } }
          if (c < 16 && !(SKIP & 8)) { const bf16* qn = F.QT + ((size_t)(((b * NH + h) * 16 + c) * 4 + lb)) * 8192 + lane_ * 8;
#pragma unroll
            for (int s = 8; s < 16; ++s) Qf[s] = *(const s16x8*)(qn + s * 512); }
        }
        RP_SB();
        asm volatile("s_waitcnt lgkmcnt(0)" ::: "memory"); __builtin_amdgcn_s_barrier(); asm volatile("" ::: "memory");
        { RP_TID();
#pragma unroll
          for (int i = 0; i < 2; ++i) { const int idx = tid_ + 512 * i, r = idx >> 3, ch = idx & 7; const int row = tok_row(c, r, b);
              if (row >= 0 && (c > 0 || b == 0)) *(v4u*)(F.YB + (size_t)row * LD_Y + h * DV + 64 * vs + 8 * ch) = *(const LAS v4u*)(OT + 144 * r + 16 * ch); } }
        { RP_LANES(); RP_TID();
          const float g128 = __builtin_amdgcn_exp2f(128.0f * lg);
#pragma unroll
          for (int r = 0; r < 16; ++r) { Sacc[0][r] *= g128; Sacc[1][r] *= g128; }
#pragma unroll
          for (int v2 = 0; v2 < 2; ++v2)
#pragma unroll
            for (int g4 = 0; g4 < 4; ++g4) { v2u o; o.x = cvtpk(Sacc[v2][4 * g4], Sacc[v2][4 * g4 + 1]); o.y = cvtpk(Sacc[v2][4 * g4 + 2], Sacc[v2][4 * g4 + 3]);
                *(LAS v2u*)(SI + (w >> 2) * 16384 + off_b(32 * v2 + lr, 4 * (w & 3) + g4) + 8 * hk) = o; }
          if (c < 16) {
#pragma unroll
            for (int s = 0; s < 8; ++s) Qf[s] = Qn[s];
          }
        }
        asm volatile("s_waitcnt vmcnt(0)" ::: "memory");
        __syncthreads();
    }
    { RP_LANES(); const float ginv = __builtin_amdgcn_exp2f(-lg);
      float* so = F.out + O_SRP + ((size_t)(lj * NBATCH + b) * NH + h) * DK * DV + 64 * vs + lr;
#pragma unroll
      for (int v2 = 0; v2 < 2; ++v2)
#pragma unroll
          for (int r = 0; r < 16; ++r) so[(size_t)(32 * w + crow(r, hk)) * DV + 32 * v2] = Sacc[v2][r] * ginv; }
    __syncthreads();
}
__device__ __forceinline__ void retention_phase(Frame& F, int lj, int what = 3) {
    const int half = F.G >> 1, me = F.vcu >> 1;
    if (what == 3 && F.G >= 2) {
        if (!(F.vcu & 1)) { for (int u = me; u < NBATCH * NH * 8; u += half) retention_prompt_mfma_unit(F, lj, u); }
        gu32* qhead = F.ctl + CW_QUEUE + 64 * lj;
        F.lane = (int)__builtin_amdgcn_mbcnt_hi(~0u, __builtin_amdgcn_mbcnt_lo(~0u, 0u)); asm volatile("" : "+v"(F.lane)); F.tid = F.wave * 64 + F.lane;
        SamplePre p0, p1;
        __syncthreads();
        if (F.tid == 0) F.MISC[16] = __hip_atomic_fetch_add(qhead, 1u, RLX_AGENT);
        __syncthreads();
        int u0 = (int)F.MISC[16];
        if (u0 < DBATCH * NH) sample_prefetch(F, u0 >> 3, u0 & 7, p0);
        while (u0 < DBATCH * NH) {
            __syncthreads();
            if (F.tid == 0) F.MISC[16] = __hip_atomic_fetch_add(qhead, 1u, RLX_AGENT);
            __syncthreads();
            const int u1 = (int)F.MISC[16];
            if (u1 < DBATCH * NH) sample_prefetch(F, u1 >> 3, u1 & 7, p1);
            retention_sample_unit(F, lj, u0 >> 3, u0 & 7, p0);
            u0 = u1; p0 = p1;
        }
        return;
    }
    if (what == 70) { if (!(F.vcu & 1)) for (int u = me; u < NBATCH * NH * 8; u += half) retention_prompt_mfma_unit(F, lj, u); return; }
    if (what == 71) { if (F.vcu & 1) for (int u = me; u < DBATCH * NH; u += half) { SamplePre pp; sample_prefetch(F, u >> 3, u & 7, pp); retention_sample_unit(F, lj, u >> 3, u & 7, pp); } return; }
    if (what >= 64) { for (int u = F.vcu; u < NBATCH * NH * 8; u += F.G) { if (what == 64) retention_prompt_mfma_unit<1>(F, lj, u); else if (what == 65) retention_prompt_mfma_unit<2>(F, lj, u); else if (what == 66) retention_prompt_mfma_unit<4>(F, lj, u); else if (what == 67) retention_prompt_mfma_unit<8>(F, lj, u); else if (what == 68) retention_prompt_mfma_unit<24>(F, lj, u); else retention_prompt_mfma_unit<0>(F, lj, u); } return; }
    if (what == 8) { for (int u = F.vcu; u < DBATCH * NH; u += F.G) { SamplePre pp; sample_prefetch(F, u >> 3, u & 7, pp); retention_sample_unit<1>(F, lj, u >> 3, u & 7, pp); } return; }
    if (what == 32) { if ((F.vcu & 3) == 3) for (int u = F.vcu >> 2; u < DBATCH * NH; u += F.G >> 2) { SamplePre pp; sample_prefetch(F, u >> 3, u & 7, pp); retention_sample_unit<1, 16>(F, lj, u >> 3, u & 7, pp); } return; }
    if (what == 16) { for (int u = F.vcu; u < DBATCH * NH; u += F.G) { SamplePre pp; sample_prefetch(F, u >> 3, u & 7, pp); retention_sample_unit<2>(F, lj, u >> 3, u & 7, pp); } return; }
    if (what & 1) for (int u = F.vcu; u < NBATCH * NH * 8; u += F.G) retention_prompt_mfma_unit(F, lj, u);
    F.lane = (int)__builtin_amdgcn_mbcnt_hi(~0u, __builtin_amdgcn_mbcnt_lo(~0u, 0u)); asm volatile("" : "+v"(F.lane)); F.tid = F.wave * 64 + F.lane;
    if (what & 2) for (int u = F.vcu; u < DBATCH * NH; u += F.G) { SamplePre pp; sample_prefetch(F, u >> 3, u & 7, pp); retention_sample_unit(F, lj, u >> 3, u & 7, pp); }
}

__device__ __forceinline__ void groupnorm_gate_phase(Frame& F) {
    const int gw = F.vcu * NWAVES + F.wave, NGW = F.G * NWAVES;
    for (int it = gw; it < M_PAD * NH; it += NGW) {
        const int row = it >> 3, h = it & 7;
        v4u* o = (v4u*)(F.A2 + (size_t)row * LD_A2 + h * DV) + F.lane;
        if (row >= ROW_S0 && row < ROW_M0) continue;
        if (row >= M_REAL) { *o = (v4u){0u, 0u, 0u, 0u}; continue; }
        const v4u yw = *((const v4u*)(F.YB + (size_t)row * LD_Y + h * DV) + F.lane);
        const f32x4 y0 = {bf_lo(yw.x), bf_hi(yw.x), bf_lo(yw.y), bf_hi(yw.y)}, y1 = {bf_lo(yw.z), bf_hi(yw.z), bf_lo(yw.w), bf_hi(yw.w)};
        const float mu = wave_sum((y0.x + y0.y) + (y0.z + y0.w) + (y1.x + y1.y) + (y1.z + y1.w)) * (1.f / DV);
        const f32x4 d0 = y0 - mu, d1 = y1 - mu;
        const float var = wave_sum((d0.x * d0.x + d0.y * d0.y) + (d0.z * d0.z + d0.w * d0.w) + (d1.x * d1.x + d1.y * d1.y) + (d1.z * d1.z + d1.w * d1.w)) * (1.f / DV);
        const float rs = 1.0f / sqrtf(var + GN_EPS);
        const v4u gw4 = *((const v4u*)(F.PROJ + (size_t)row * LD_PROJ + 2 * RQK + RV + h * DV) + F.lane);
        float g[8] = {bf_lo(gw4.x), bf_hi(gw4.x), bf_lo(gw4.y), bf_hi(gw4.y), bf_lo(gw4.z), bf_hi(gw4.z), bf_lo(gw4.w), bf_hi(gw4.w)};
        float yn[8] = {d0.x * rs, d0.y * rs, d0.z * rs, d0.w * rs, d1.x * rs, d1.y * rs, d1.z * rs, d1.w * rs};
        float r[8];
#pragma unroll
        for (int j = 0; j < 8; ++j) r[j] = g[j] / (1.0f + __expf(-g[j])) * yn[j];
        v4u w; w.x = pk2(r[0], r[1]); w.y = pk2(r[2], r[3]); w.z = pk2(r[4], r[5]); w.w = pk2(r[6], r[7]);
        *o = w;
    }
}

__device__ __forceinline__ void layernorm_phase(Frame& F, int layer, bool last) {
    const int gw = F.vcu * NWAVES + F.wave, NGW = F.G * NWAVES;
    for (int row = gw; row < M_PAD; row += NGW) {
        float v[4][8]; float s = 0.f;
        if (row < ROW_S0) {
            const v4u* hp = (const v4u*)(F.HB + (size_t)row * LD_X) + F.lane;
#pragma unroll
            for (int j = 0; j < 4; ++j) { const v4u w = hp[64 * j]; v[j][0] = bf_lo(w.x); v[j][1] = bf_hi(w.x); v[j][2] = bf_lo(w.y); v[j][3] = bf_hi(w.y); v[j][4] = bf_lo(w.z); v[j][5] = bf_hi(w.z); v[j][6] = bf_lo(w.w); v[j][7] = bf_hi(w.w); }
        } else {
            const v4u* xp = (const v4u*)(F.XB + (size_t)row * LD_X) + F.lane; const v4u* pp = (const v4u*)((const bf16*)F.PART + (size_t)(row - ROW_S0) * DM) + F.lane;
#pragma unroll
            for (int j = 0; j < 4; ++j) { const v4u w = xp[64 * j];
                f32x4 a0 = (f32x4){bf_lo(w.x), bf_hi(w.x), bf_lo(w.y), bf_hi(w.y)} * DN_ALPHA, a1 = (f32x4){bf_lo(w.z), bf_hi(w.z), bf_lo(w.w), bf_hi(w.w)} * DN_ALPHA;
#pragma unroll
                for (int k = 0; k < TAIL_KS; ++k) { const v4u q = pp[(size_t)k * (M_PAD - ROW_S0) * (DM / 8) + 64 * j];
                    a0 += (f32x4){bf_lo(q.x), bf_hi(q.x), bf_lo(q.y), bf_hi(q.y)}; a1 += (f32x4){bf_lo(q.z), bf_hi(q.z), bf_lo(q.w), bf_hi(q.w)}; }
                v[j][0] = a0.x; v[j][1] = a0.y; v[j][2] = a0.z; v[j][3] = a0.w; v[j][4] = a1.x; v[j][5] = a1.y; v[j][6] = a1.z; v[j][7] = a1.w; }
        }
#pragma unroll
        for (int j = 0; j < 4; ++j)
#pragma unroll
            for (int e = 0; e < 8; ++e) s += v[j][e];
        const float mean = wave_sum(s) * (1.f / DM); float s2 = 0.f;
#pragma unroll
        for (int j = 0; j < 4; ++j)
#pragma unroll
            for (int e = 0; e < 8; ++e) { v[j][e] -= mean; s2 += v[j][e] * v[j][e]; }
        const float rstd = 1.f / sqrtf(wave_sum(s2) * (1.f / DM) + LN_EPS);
        const f32x4* gp = (const f32x4*)(F.ln_g + (size_t)layer * DM) + 2 * F.lane; const f32x4* bp = (const f32x4*)(F.ln_b + (size_t)layer * DM) + 2 * F.lane;
        v4u* xb = (v4u*)(F.XB + (size_t)row * LD_X) + F.lane;
        f32x4* od = nullptr;
        if (last) { if (row < ROW_S0) od = (f32x4*)(F.out + O_YP + (size_t)row * DM) + 2 * F.lane; else if (row < ROW_M0) od = (f32x4*)(F.out + O_YS + (size_t)(row - ROW_S0) * DM) + 2 * F.lane; }
#pragma unroll
        for (int j = 0; j < 4; ++j) { const f32x4 g0 = gp[128 * j], g1 = gp[128 * j + 1], b0 = bp[128 * j], b1 = bp[128 * j + 1];
            const f32x4 y0 = (f32x4){v[j][0], v[j][1], v[j][2], v[j][3]} * rstd * g0 + b0, y1 = (f32x4){v[j][4], v[j][5], v[j][6], v[j][7]} * rstd * g1 + b1;
            if (last) { if (od) { od[128 * j] = y0; od[128 * j + 1] = y1; } }
            else { v4u o; o.x = pk2(y0.x, y0.y); o.y = pk2(y0.z, y0.w); o.z = pk2(y1.x, y1.y); o.w = pk2(y1.z, y1.w); xb[64 * j] = o; } }
    }
}

__device__ __forceinline__ void conv_phase(Frame& F, int lj) {
    const int gt = F.vcu * NWAVES * 64 + F.tid, NGT = F.G * NWAVES * 64;
    const float* cw = F.conv_w + (size_t)lj * 3 * DM;
    for (int it = gt; it < (2 * (ROW_S0 / 256) + M_PAD - ROW_S0) * (DM / 8); it += NGT) {
        const int ri = it >> 8, e0 = (it & 255) * 8; const int row = ri < 2 * (ROW_S0 / 256) ? (ri >> 1) * 256 + (ri & 1) : ROW_S0 + (ri - 2 * (ROW_S0 / 256));
        v4u* o = (v4u*)(F.A2 + (size_t)row * LD_X + e0);
        if (row >= M_REAL) { *o = (v4u){0u, 0u, 0u, 0u}; continue; }
        int r1, r2;
        if (row < ROW_S0) { const int t = row & (SEQ - 1); r1 = t >= 1 ? row - 1 : ROW_M0 + 15; r2 = t >= 2 ? row - 2 : (t == 1 ? ROW_M0 + 15 : ROW_M0 + 14); }
        else if (row < ROW_M0) { const int s = (row - ROW_S0) & (DSEQ - 1); r1 = s >= 1 ? row - 1 : -3; r2 = s >= 2 ? row - 2 : (s == 1 ? -3 : -2); }
        else { const int j = row - ROW_M0; r1 = j >= 1 ? row - 1 : -1; r2 = j >= 2 ? row - 2 : -1; }
        float u0[8], u1[8], u2[8];
        const bf16* pr = F.PROJ + (size_t)row * LD_PROJ + e0;
        { const v4u w = *(const v4u*)pr; u0[0] = bf_lo(w.x); u0[1] = bf_hi(w.x); u0[2] = bf_lo(w.y); u0[3] = bf_hi(w.y); u0[4] = bf_lo(w.z); u0[5] = bf_hi(w.z); u0[6] = bf_lo(w.w); u0[7] = bf_hi(w.w); }
#pragma unroll
        for (int k = 1; k <= 2; ++k) {
            const int rr = k == 1 ? r1 : r2; float* uu = k == 1 ? u1 : u2;
            if (rr >= 0) { const v4u w = *(const v4u*)(F.PROJ + (size_t)rr * LD_PROJ + e0);
                uu[0] = bf_lo(w.x); uu[1] = bf_hi(w.x); uu[2] = bf_lo(w.y); uu[3] = bf_hi(w.y); uu[4] = bf_lo(w.z); uu[5] = bf_hi(w.z); uu[6] = bf_lo(w.w); uu[7] = bf_hi(w.w); }
            else if (rr == -1) {
#pragma unroll
                for (int j = 0; j < 8; ++j) uu[j] = 0.f; }
            else { const int srow = -2 - rr; const int sb = (row - ROW_S0) >> 3; const float* sp = F.state_conv + (((size_t)lj * DBATCH + sb) * 2 + srow) * DM + e0;
                const f32x4 a = *(const f32x4*)sp, bq = *(const f32x4*)(sp + 4); uu[0] = a.x; uu[1] = a.y; uu[2] = a.z; uu[3] = a.w; uu[4] = bq.x; uu[5] = bq.y; uu[6] = bq.z; uu[7] = bq.w; }
        }
        const v4u gg = *(const v4u*)(pr + DM);
        const float gf[8] = {bf_lo(gg.x), bf_hi(gg.x), bf_lo(gg.y), bf_hi(gg.y), bf_lo(gg.z), bf_hi(gg.z), bf_lo(gg.w), bf_hi(gg.w)};
        float r[8];
#pragma unroll
        for (int j = 0; j < 8; ++j) r[j] = gf[j] * (cw[e0 + j] * u2[j] + cw[DM + e0 + j] * u1[j] + cw[2 * DM + e0 + j] * u0[j]);
        v4u w; w.x = pk2(r[0], r[1]); w.y = pk2(r[2], r[3]); w.z = pk2(r[4], r[5]); w.w = pk2(r[6], r[7]); *o = w;
    }
}

#define IN(k) (lo <= (k) && (k) < hi)
#define OPAQUE(p) asm volatile("" : "+s"(p))
#define FRESH() do { F.lane = (int)__builtin_amdgcn_mbcnt_hi(~0u, __builtin_amdgcn_mbcnt_lo(~0u, 0u)); asm volatile("" : "+v"(F.lane)); F.tid = F.wave * 64 + F.lane; asm volatile("" : "+s"(F.vcu)); } while (0)
#define SEAM(k) do { if (IN((k) + 1)) xcd_barrier(bar); } while (0)
#define SEAM2(k) do { if (IN((k) + 2)) xcd_barrier(bar); } while (0)

#ifndef GEMM_ALIGN
#define GEMM_ALIGN true
#endif
#ifndef GEMM_SP2
#define GEMM_SP2 true
#endif
#ifndef MK_PROBE
#define MK_PROBE 0
#endif
#define PROBE_REP(mask, call) do { if ((MK_PROBE) & (mask)) { xcd_barrier(bar); call; } } while (0)
template <int lj> __device__ __forceinline__ void gemm_ret_in(Frame& F) {
    const bf16* gA = F.XB; const bf16* gB = F.Wri + (size_t)lj * NRI * LD_X; OPAQUE(gA); OPAQUE(gB); pg8::Gemm g{gA, gB, M_PAD, NRI, DM, LD_X}; pg8::StaticOrder S; S.init(M_PAD, NRI, DM, F.G, (int)blockIdx.x);
    EpiRopeBf16 E{F.PROJ, LD_PROJ, F.ROPE, F.QT};
    pg8::gemm_phase<EpiRopeBf16, pg8::StaticOrder, GEMM_ALIGN, GEMM_SP2>(F.lds + RING_OFF, g, S, E, F.wave);
}
template <int lj> __device__ __forceinline__ void gemm_ret_out(Frame& F) {
    const bf16* gA = F.A2; const bf16* gB = F.Wro + (size_t)lj * DM * LD_A2; OPAQUE(gA); OPAQUE(gB); pg8::Gemm g{gA, gB, M_PAD, DM, RV, LD_A2}; pg8::TailOrder S; S.init(ROW_S0, M_PAD, DM, g.K, TAIL_KS, F.G, (int)blockIdx.x);
    EpiResBf16 E{F.HB, F.XB, F.PART, DN_ALPHA};
    pg8::gemm_phase<EpiResBf16, pg8::TailOrder, GEMM_ALIGN, GEMM_SP2>(F.lds + RING_OFF, g, S, E, F.wave);
}
template <int lj> __device__ __forceinline__ void gemm_conv_in(Frame& F) {
    const bf16* gA = F.XB; const bf16* gB = F.Wci + (size_t)lj * NCI * LD_X; OPAQUE(gA); OPAQUE(gB); pg8::Gemm g{gA, gB, M_PAD, NCI, DM, LD_X}; pg8::StaticOrder S; S.init(M_PAD, NCI, DM, F.G, (int)blockIdx.x);
    EpiConvGate E{F.PROJ, F.out + O_SCP + (size_t)lj * NBATCH * 2 * DM, F.out + O_SCS + (size_t)lj * DBATCH * 2 * DM, F.A2, F.conv_w + (size_t)lj * 3 * DM, (LAS float*)(F.lds + RING_OFF + 131072)};
    pg8::gemm_phase<EpiConvGate, pg8::StaticOrder, GEMM_ALIGN, GEMM_SP2>(F.lds + RING_OFF, g, S, E, F.wave);
}
template <int lj> __device__ __forceinline__ void gemm_conv_out(Frame& F) {
    const bf16* gA = F.A2; const bf16* gB = F.Wco + (size_t)lj * DM * LD_X; OPAQUE(gA); OPAQUE(gB); pg8::Gemm g{gA, gB, M_PAD, DM, DM, LD_X}; pg8::TailOrder S; S.init(ROW_S0, M_PAD, DM, g.K, TAIL_KS, F.G, (int)blockIdx.x);
    EpiResBf16 E{F.HB, F.XB, F.PART, DN_ALPHA};
    pg8::gemm_phase<EpiResBf16, pg8::TailOrder, GEMM_ALIGN, GEMM_SP2>(F.lds + RING_OFF, g, S, E, F.wave);
}
struct EpiNull { static constexpr bool PERM = true, AFTER_DRAIN = false; float* sink;
    __device__ __forceinline__ void operator()(const pg8::f32x4 (&acc)[2][2][4][2], const pg8::Unit& u, int wr, int wc, int fr, int fq) const { pg8::f32x4 t = {0.f, 0.f, 0.f, 0.f};
#pragma unroll
        for (int a = 0; a < 2; ++a)
#pragma unroll
            for (int b = 0; b < 2; ++b)
#pragma unroll
                for (int m = 0; m < 4; ++m) { t += acc[a][b][m][0]; t += acc[a][b][m][1]; }
        if (t[0] + t[1] + t[2] + t[3] == 123456.789f) sink[0] = 1.f; } };
template <int lj, int which> __device__ __forceinline__ void gemm_null(Frame& F) {
    const bf16* gA = (which == 0 || which == 2) ? F.XB : F.A2;
    const bf16* gB = which == 0 ? F.Wri + (size_t)lj * NRI * LD_X : which == 1 ? F.Wro + (size_t)lj * DM * LD_A2 : which == 2 ? F.Wci + (size_t)lj * NCI * LD_X : F.Wco + (size_t)lj * DM * LD_X;
    OPAQUE(gA); OPAQUE(gB);
    constexpr int N = which == 0 ? NRI : which == 2 ? NCI : DM, K = which == 1 ? RV : DM, LD = which == 1 ? LD_A2 : LD_X;
    pg8::Gemm g{gA, gB, M_PAD, N, K, LD}; EpiNull E{F.PART};
    if (which == 0 || which == 2) { pg8::StaticOrder S; S.init(M_PAD, N, K, F.G, (int)blockIdx.x); pg8::gemm_phase<EpiNull, pg8::StaticOrder, GEMM_ALIGN, GEMM_SP2>(F.lds + RING_OFF, g, S, E, F.wave); }
    else { pg8::TailOrder S; S.init(ROW_S0, M_PAD, N, K, TAIL_KS, F.G, (int)blockIdx.x); pg8::gemm_phase<EpiNull, pg8::TailOrder, GEMM_ALIGN, GEMM_SP2>(F.lds + RING_OFF, g, S, E, F.wave); }
}
constexpr int N_TAIL_UNITS = (M_PAD - ROW_S0) / 256 * (DM / 256) * TAIL_KS;
template <int lj> __device__ __forceinline__ void layer_pair(Frame& F, const XcdBarrier& bar, const int lo, const int hi) {
    const int pb = 1 + 10 * lj;
    if (IN(pb + 0)) { if ((MK_PROBE) & 512) { gemm_null<lj, 0>(F); xcd_barrier(bar); } gemm_ret_in<lj>(F); PROBE_REP(2, gemm_ret_in<lj>(F)); SEAM(pb + 0); }
    if (IN(pb + 2)) { if ((MK_PROBE) & 64) { FRESH(); retention_phase(F, lj, 8); xcd_barrier(bar); } if ((MK_PROBE) & 128) { FRESH(); retention_phase(F, lj, 16); xcd_barrier(bar); } if ((MK_PROBE) & 256) { FRESH(); retention_phase(F, lj, 32); xcd_barrier(bar); } if ((MK_PROBE) >= 1024) { FRESH(); retention_phase(F, lj, 64 + ((MK_PROBE) >> 10) - 1); xcd_barrier(bar); } FRESH(); retention_phase(F, lj); PROBE_REP(4, FRESH(); retention_phase(F, lj)); PROBE_REP(16, FRESH(); retention_phase(F, lj, 1)); PROBE_REP(32, FRESH(); retention_phase(F, lj, 2)); SEAM(pb + 2); }
    if (IN(pb + 3)) { FRESH(); groupnorm_gate_phase(F); PROBE_REP(8, FRESH(); groupnorm_gate_phase(F)); SEAM(pb + 3); }
    if (IN(pb + 4)) { if ((MK_PROBE) & 512) { gemm_null<lj, 1>(F); xcd_barrier(bar); } gemm_ret_out<lj>(F); if (MK_DEFER_CVT) convert_by_idle<(0x4 << (4 * lj))>(F, N_TAIL_UNITS); PROBE_REP(2, gemm_ret_out<lj>(F)); SEAM(pb + 4); }
    if (IN(pb + 5)) { FRESH(); layernorm_phase(F, 2 * lj, false); SEAM(pb + 5); }
    if (IN(pb + 6)) { if ((MK_PROBE) & 512) { gemm_null<lj, 2>(F); xcd_barrier(bar); } gemm_conv_in<lj>(F); if (MK_DEFER_CVT) convert_by_idle<(lj == 0 ? 0x18 : 0x80)>(F, (M_PAD / 256) * (NCI / 256) % 256); PROBE_REP(2, gemm_conv_in<lj>(F)); SEAM(pb + 6); }
    if (IN(pb + 7)) { FRESH(); conv_phase(F, lj); PROBE_REP(8, FRESH(); conv_phase(F, lj)); SEAM(pb + 7); }
    if (IN(pb + 8)) { if ((MK_PROBE) & 512) { gemm_null<lj, 3>(F); xcd_barrier(bar); } gemm_conv_out<lj>(F); if (MK_DEFER_CVT) convert_by_idle<(lj == 0 ? 0x20 : 0)>(F, N_TAIL_UNITS); PROBE_REP(2, gemm_conv_out<lj>(F)); SEAM(pb + 8); }
    if (IN(pb + 9)) { FRESH(); layernorm_phase(F, 2 * lj + 1, lj == 1); SEAM(pb + 9); }
}

constexpr int NPHASE = 21;
struct Args { const float* in[12]; float* out; unsigned char* ws; float freq[128]; int ph_lo, ph_hi; };
__global__ void __launch_bounds__(NWAVES * 64, 2) mk_fwd(Args args) {
    extern __shared__ __attribute__((aligned(16))) unsigned char lds[];
    Frame F;
    F.lds = (LAS unsigned char*)lds;
    F.MISC = (volatile LAS unsigned*)(F.lds + MISC_OFF);
    F.tid = threadIdx.x; F.lane = F.tid & 63; F.wave = __builtin_amdgcn_readfirstlane(F.tid >> 6);
    F.G = gridDim.x; { const int bx = blockIdx.x; F.vcu = (F.G % 8 == 0) ? (bx % 8) * (F.G / 8) + bx / 8 : bx; }
    unsigned char* ws = args.ws;
    F.ctl = (gu32*)(ws + WS_CTL);
    F.x_prompt = args.in[0]; F.x_sample = args.in[1]; F.state_ret = args.in[2]; F.state_conv = args.in[3]; F.meta = args.in[4]; F.w_ret_in = args.in[5];
    F.w_ret_out = args.in[6]; F.w_conv_in = args.in[7]; F.conv_w = args.in[8]; F.w_conv_out = args.in[9]; F.ln_g = args.in[10]; F.ln_b = args.in[11];
    F.out = args.out;
    F.Wri = (bf16*)(ws + WS_WRI); F.Wro = (bf16*)(ws + WS_WRO); F.Wci = (bf16*)(ws + WS_WCI); F.Wco = (bf16*)(ws + WS_WCO);
    F.XB = (bf16*)(ws + WS_XB); F.PROJ = (bf16*)(ws + WS_PROJ); F.A2 = (bf16*)(ws + WS_A2);
    F.HB = (bf16*)(ws + WS_H); F.QT = (bf16*)(ws + WS_XF); F.PART = (float*)(ws + WS_PART); F.YF = (float*)(ws + WS_YF); F.YB = (bf16*)(ws + WS_YF); F.ROPE = (float*)(ws + WS_ROPE);
    for (int u = F.tid; u < (LDS_BYTES - LDSCTL_OFF) / 4; u += NWAVES * 64) ((LAS unsigned*)(F.lds + LDSCTL_OFF))[u] = 0u;
    __syncthreads();
    XcdBarrier bar; bar.bar = (unsigned*)(F.ctl + CW_BAR); bar.x = 0; bar.st = nullptr;
    if (MK_N_LAUNCHES == 1) bar = xcd_barrier_post((unsigned*)(F.ctl + CW_BAR), F.MISC + 8);
    const int lo = args.ph_lo, hi = args.ph_hi;
    if (IN(0)) { FRESH(); p0_prologue(F, args.freq); PROBE_REP(1, FRESH(); p0_prologue(F, args.freq)); SEAM(0); }
    layer_pair<0>(F, bar, lo, hi);
    layer_pair<1>(F, bar, lo, hi);
#undef IN
#undef SEAM
}

extern "C" void kernel_launch(void* const* d_in, const int* in_sizes, int n_in, void* d_out, int out_size, void* d_ws, size_t ws_size, hipStream_t stream) {
    static int grid = 0;
    if (grid == 0) {
        if (n_in != 12 || (size_t)out_size != O_END || ws_size < WS_END) { fprintf(stderr, "kernel_launch: unexpected shapes: n_in %d out %d ws %zu (need %zu)\n", n_in, out_size, ws_size, (size_t)WS_END); grid = -1; return; }
        int dev = 0, cus = 0, per_cu = 0;
        if (hipGetDevice(&dev) != hipSuccess || hipDeviceGetAttribute(&cus, hipDeviceAttributeMultiprocessorCount, dev) != hipSuccess) { grid = -1; return; }
        if (hipFuncSetAttribute((const void*)mk_fwd, hipFuncAttributeMaxDynamicSharedMemorySize, LDS_BYTES) != hipSuccess) { fprintf(stderr, "kernel_launch: hipFuncSetAttribute failed\n"); grid = -1; return; }
        if (hipOccupancyMaxActiveBlocksPerMultiprocessor(&per_cu, (const void*)mk_fwd, NWAVES * 64, LDS_BYTES) != hipSuccess || per_cu < 1) { fprintf(stderr, "kernel_launch: occupancy query says %d blocks per CU\n", per_cu); }
        (void)hipGetLastError();
        grid = cus;
    }
    if (grid < 0) return;
    if (hipMemsetAsync((char*)d_ws + WS_CTL, 0, CTL_ZERO_BYTES, stream) != hipSuccess) { fprintf(stderr, "kernel_launch: memset failed\n"); return; }
    Args a{};
    for (int i = 0; i < 12; ++i) a.in[i] = (const float*)d_in[i];
    a.out = (float*)d_out; a.ws = (unsigned char*)d_ws;
    for (int d = 0; d < 128; ++d) a.freq[d] = (float)pow(10000.0, -(double)d / 128.0);
#if MK_N_LAUNCHES == 1
    a.ph_lo = 0; a.ph_hi = NPHASE;
    hipLaunchKernelGGL(mk_fwd, dim3(grid), dim3(NWAVES * 64), LDS_BYTES, stream, a);
#else
    for (int p = 0; p < NPHASE; ++p) { a.ph_lo = p; a.ph_hi = p + 1; hipLaunchKernelGGL(mk_fwd, dim3(grid), dim3(NWAVES * 64), LDS_BYTES, stream, a); }
#endif
    const hipError_t le = hipPeekAtLastError();
    if (le != hipSuccess) fprintf(stderr, "kernel_launch: launch failed: %s\n", hipGetErrorName(le));
}
```

```cpp
#include <hip/hip_runtime.h>
#include <cstdio>
#include <cstdint>
#include <cmath>
namespace pg8 {
#define PG8_LAS __attribute__((address_space(3)))
typedef unsigned short bf16_t;
typedef short bf16x8 __attribute__((ext_vector_type(8)));
typedef float f32x4 __attribute__((ext_vector_type(4)));
typedef unsigned u32x4 __attribute__((ext_vector_type(4)));
constexpr int BM = 256, BK = 64, HALF = 128, HTB = HALF * BK * 2  , STAGE_BYTES = 8 * HTB, NXCD = 8, WGM = 8;

__host__ __device__ __forceinline__ int lds_byte(int r, int c) { const int st = (r >> 4) * 2 + (c >> 5), rr = r & 15, cc = c & 31, ob = rr * 64 + cc * 2; return st * 1024 + (ob ^ (((ob >> 9) & 1) << 5)); }
__host__ __device__ __forceinline__ void stage_rc(int b, int& R, int& C) { const int st = b / 1024, sb = b % 1024, swz = sb ^ (((sb >> 9) & 1) << 5); R = (st >> 1) * 16 + swz / 64; C = (st & 1) * 32 + (swz % 64) / 2; }
__host__ __device__ __forceinline__ int perm32(int rho) { const int n = rho >> 4, i = rho & 15; return 8 * (i >> 2) + 4 * n + (i & 3); }

struct Unit { int pm, pn; };
__host__ __device__ __forceinline__ int unit_pn(const Unit& u) { return u.pn & 255; }
__host__ __device__ __forceinline__ int unit_part(const Unit& u) { return (u.pn >> 8) - 1; }
struct Gemm { const bf16_t* A; const bf16_t* Bt; int M, N, K, ld; };

struct StaticOrder {
    int nM, nN, nwg, G, c, ntf;
    __host__ __device__ __forceinline__ void init(int M, int N, int K, int G_, int c_) { nM = M / BM; nN = N / BM; nwg = nM * nN; G = G_; c = c_; ntf = K / BK; }
    __host__ __device__ __forceinline__ bool next(int i, Unit& u) const {
        const long L = (long)i * G + c; if (L >= nwg) return false;
        int wgid = (int)L; { const int q = nwg / NXCD, r = nwg % NXCD, xcd = wgid % NXCD, off = wgid / NXCD; wgid = (xcd < r ? xcd * (q + 1) : r * (q + 1) + (xcd - r) * q) + off; }
        const int nig = WGM * nN, gid = wgid / nig, fm = gid * WGM, gsz = (nM - fm) < WGM ? (nM - fm) : WGM;
        u.pm = fm + ((wgid % nig) % gsz); u.pn = (wgid % nig) / gsz; return true;
    }
    __device__ __forceinline__ void a_ready(const Unit&) const {}
    __device__ __forceinline__ void done(const Unit&) const {}
    __device__ __forceinline__ int nt_of(const Unit&) const { return ntf; }
    __device__ __forceinline__ int k0_of(const Unit&) const { return 0; }
};
struct TailOrder {
    StaticOrder full; int nMf, nMt, nN, G, c, KS, ntp, nfull;
    __host__ __device__ __forceinline__ void init(int Mfull, int M, int N, int K, int KS_, int G_, int c_) { full.init(Mfull, N, K, G_, c_); nMf = Mfull / BM; nMt = M / BM - nMf; nN = N / BM; G = G_; c = c_; KS = KS_; ntp = K / BK / KS_; nfull = nMf * nN; }
    __host__ __device__ __forceinline__ bool next(int i, Unit& u) const {
        const long L = (long)i * G + c;
        if (L < nfull) return full.next(i, u);
        const int j = (int)(L - nfull); if (j >= nMt * nN * KS) return false;
        const int tile = j / KS; u.pm = nMf + tile % nMt; u.pn = tile / nMt + 256 * (1 + j % KS); return true;
    }
    __device__ __forceinline__ void a_ready(const Unit&) const {}
    __device__ __forceinline__ void done(const Unit&) const {}
    __device__ __forceinline__ int nt_of(const Unit& u) const { return (u.pn >> 8) ? ntp : full.ntf; }
    __device__ __forceinline__ int k0_of(const Unit& u) const { const int p = u.pn >> 8; return p ? (p - 1) * ntp * BK : 0; }
};


__device__ __forceinline__ unsigned cvt_pk_bf16(float lo, float hi) { unsigned r; asm volatile("v_cvt_pk_bf16_f32 %0, %1, %2" : "=v"(r) : "v"(lo), "v"(hi)); return r; }
typedef float f32x2 __attribute__((ext_vector_type(2)));
__device__ __forceinline__ f32x2 gelu_pk(f32x2 v) {
    const f32x2 av = __builtin_elementwise_abs(v), d = av * 0.2316418882f + 1.0f;
    f32x2 t; t.x = __builtin_amdgcn_rcpf(d.x); t.y = __builtin_amdgcn_rcpf(d.y);
    f32x2 q = t * 0.5307027145f + (-0.7265760135f); q = q * t + 0.7107068705f; q = q * t + (-0.142248368f); q = q * t + 0.127414796f; q = q * t;
    const f32x2 s = (v * v) * (-0.72134752044f);
    f32x2 e; e.x = __builtin_amdgcn_exp2f(s.x); e.y = __builtin_amdgcn_exp2f(s.y);
    const f32x2 m = v * (q * e), r = v - m;
    f32x2 o; o.x = v.x < 0.f ? m.x : r.x; o.y = v.y < 0.f ? m.y : r.y; return o;
}

template <int ACT  > struct EpiBf16 {
    static constexpr bool PERM = true, AFTER_DRAIN = false; static_assert(ACT == 0 || ACT == 1, "EpiBf16: ACT is 0 (none) or 1 (gelu_pk)");
    bf16_t* O; int ldc; const float* bias; int split_cols; size_t split_stride; float scale0;
    __device__ __forceinline__ void operator()(const f32x4 (&acc)[2][2][4][2], const Unit& u, int wr, int wc, int fr, int fq) const {
        const int row0 = u.pm * BM + wr * 64 + fr; int colt = u.pn * BM; bf16_t* base = O;
        float sc = 1.f; if (split_cols) { const int t = colt / split_cols; base += (size_t)t * split_stride; colt -= t * split_cols; if (t == 0) sc = scale0; }
        const int col0 = colt + wc * 32 + 8 * fq, bcol0 = u.pn * BM + wc * 32 + 8 * fq;
        f32x4 bv[2][2];
#pragma unroll
        for (int bj = 0; bj < 2; ++bj)
#pragma unroll
            for (int n = 0; n < 2; ++n) bv[bj][n] = bias ? *(const f32x4*)(bias + bcol0 + bj * HALF + 4 * n) : (f32x4){0.f, 0.f, 0.f, 0.f};
#pragma unroll
        for (int ai = 0; ai < 2; ++ai)
#pragma unroll
            for (int m = 0; m < 4; ++m) { bf16_t* rowp = base + (size_t)(row0 + ai * HALF + m * 16) * ldc + col0;
#pragma unroll
                for (int bj = 0; bj < 2; ++bj) { f32x4 v0 = acc[ai][bj][m][0] + bv[bj][0], v1 = acc[ai][bj][m][1] + bv[bj][1];
                    if (ACT == 1) { f32x2 a = gelu_pk((f32x2){v0[0], v0[1]}), b = gelu_pk((f32x2){v0[2], v0[3]}), c = gelu_pk((f32x2){v1[0], v1[1]}), d = gelu_pk((f32x2){v1[2], v1[3]});
                        v0 = (f32x4){a.x, a.y, b.x, b.y}; v1 = (f32x4){c.x, c.y, d.x, d.y}; }
                    v0 = v0 * sc; v1 = v1 * sc; u32x4 w; w.x = cvt_pk_bf16(v0[0], v0[1]); w.y = cvt_pk_bf16(v0[2], v0[3]); w.z = cvt_pk_bf16(v1[0], v1[1]); w.w = cvt_pk_bf16(v1[2], v1[3]);
                    *(u32x4*)(rowp + bj * HALF) = w; } }
    }
};

template <class Epi, class Sched, bool ALIGN_EPI = false, bool SP2 = false>
__device__ __forceinline__ void gemm_phase(PG8_LAS unsigned char* lds, const Gemm g, const Sched& S, const Epi& E, const int wave_idx) {
    int tid_ = (int)__builtin_amdgcn_mbcnt_hi(~0u, __builtin_amdgcn_mbcnt_lo(~0u, 0u)); asm volatile("" : "+v"(tid_)); tid_ += 64 * wave_idx;
    const int tid = tid_, wid = __builtin_amdgcn_readfirstlane(tid >> 6), lane = tid & 63, wr = wid >> 2, wc = wid & 3, fr = lane & 15, fq = lane >> 4;
    const int K = g.K;
    unsigned voffA[2], voffB[2];
#pragma unroll
    for (int i = 0; i < 2; ++i) { int R, C; stage_rc(tid * 16 + i * 8192, R, C); const int Rb = Epi::PERM ? ((R & ~31) + perm32(R & 31)) : R;
        voffA[i] = (unsigned)(R * g.ld + C) * 2u; voffB[i] = (unsigned)(Rb * g.ld + C) * 2u; }
    const size_t kstep = (size_t)(BK * 2);
    const size_t hstep = (size_t)HALF * g.ld * 2;
    const size_t tstep = 2 * hstep;
    const unsigned ldsw = (unsigned)wid * 1024u;
    const int aoff = lds_byte(wr * 64 + fr, fq * 8), boff = lds_byte(wc * 32 + fr, fq * 8);
#define PG8_SA(b, h) (((b) * 2 + (h)) * HTB)
#define PG8_SB(b, h) ((4 + (b) * 2 + (h)) * HTB)
#define PG8_STAGE(bufoff, gbase, voff) do { _Pragma("unroll") for (int _i = 0; _i < 2; ++_i) \
        __builtin_amdgcn_global_load_lds((const unsigned*)((const char*)(gbase) + (voff)[_i]), (PG8_LAS unsigned*)(lds + (bufoff) + ldsw + _i * 8192), 16, 0, 0); } while (0)
#define PG8_LDA(dst, b, h) do { _Pragma("unroll") for (int m = 0; m < 4; ++m) _Pragma("unroll") for (int k = 0; k < 2; ++k) dst[m][k] = *(const PG8_LAS bf16x8*)(lds + PG8_SA(b, h) + aoff + m * 2048 + k * 1024); } while (0)
#define PG8_LDB(dst, b, h) do { _Pragma("unroll") for (int n = 0; n < 2; ++n) _Pragma("unroll") for (int k = 0; k < 2; ++k) dst[n][k] = *(const PG8_LAS bf16x8*)(lds + PG8_SB(b, h) + boff + n * 2048 + k * 1024); } while (0)
#define PG8_MMA(ai, bj, At, Bt) do { __builtin_amdgcn_s_setprio(1); _Pragma("unroll") for (int m = 0; m < 4; ++m) _Pragma("unroll") for (int n = 0; n < 2; ++n) _Pragma("unroll") for (int k = 0; k < 2; ++k) \
        acc[ai][bj][m][n] = __builtin_amdgcn_mfma_f32_16x16x32_bf16(Bt[n][k], At[m][k], acc[ai][bj][m][n], 0, 0, 0); __builtin_amdgcn_s_setprio(0); } while (0)
#define PG8_WAIT_V(n) asm volatile("s_waitcnt vmcnt(" #n ")" ::: "memory")
#define PG8_WAIT_L(n) asm volatile("s_waitcnt lgkmcnt(" #n ")" ::: "memory")
#define PG8_BAR __builtin_amdgcn_s_barrier()
#define PG8_SCHED __builtin_amdgcn_sched_barrier(0)
    Unit cur, nxt; int ui = 0;
    if (!S.next(0, cur)) return;
    f32x4 acc[2][2][4][2];
#pragma unroll
    for (int a = 0; a < 2; ++a)
#pragma unroll
        for (int b = 0; b < 2; ++b)
#pragma unroll
            for (int m = 0; m < 4; ++m)
#pragma unroll
                for (int n = 0; n < 2; ++n) acc[a][b][m][n] = (f32x4){0.f, 0.f, 0.f, 0.f};
    bf16x8 At[4][2], B0[2][2], B1[2][2];
    const char* cA = (const char*)g.A + (size_t)cur.pm * tstep + (size_t)S.k0_of(cur) * 2; const char* cB = (const char*)g.Bt + (size_t)unit_pn(cur) * tstep + (size_t)S.k0_of(cur) * 2;
    int nt = S.nt_of(cur);
    S.a_ready(cur);
    if constexpr (SP2) {
        PG8_STAGE(PG8_SB(0, 0), cB, voffB); PG8_STAGE(PG8_SB(0, 1), cB + hstep, voffB); PG8_STAGE(PG8_SA(0, 0), cA, voffA); PG8_STAGE(PG8_SA(0, 1), cA + hstep, voffA);
        if (wr == 1) PG8_BAR;
        PG8_WAIT_V(2); PG8_BAR;
        PG8_STAGE(PG8_SB(1, 0), cB + kstep, voffB); PG8_STAGE(PG8_SA(1, 0), cA + kstep, voffA); PG8_STAGE(PG8_SB(1, 1), cB + hstep + kstep, voffB);
        PG8_WAIT_V(6); PG8_BAR;
    } else {
        PG8_STAGE(PG8_SB(0, 0), cB, voffB); PG8_STAGE(PG8_SA(0, 0), cA, voffA); PG8_STAGE(PG8_SB(0, 1), cB + hstep, voffB); PG8_STAGE(PG8_SA(0, 1), cA + hstep, voffA);
        if (wr == 1) PG8_BAR;
        PG8_WAIT_V(4); PG8_BAR;
        PG8_STAGE(PG8_SB(1, 0), cB + kstep, voffB); PG8_STAGE(PG8_SA(1, 0), cA + kstep, voffA); PG8_STAGE(PG8_SB(1, 1), cB + hstep + kstep, voffB);
        PG8_WAIT_V(6); PG8_BAR;
    }
    for (;;) {
        const bool has_next = S.next(ui + 1, nxt);
        const char* nA = has_next ? (const char*)g.A + (size_t)nxt.pm * tstep + (size_t)S.k0_of(nxt) * 2 : cA; const char* nB = has_next ? (const char*)g.Bt + (size_t)unit_pn(nxt) * tstep + (size_t)S.k0_of(nxt) * 2 : cB;
        for (int t = 0; t < nt; t += 2) {
            const bool last = (t == nt - 2);
            const char* a1 = cA + (size_t)(t + 1) * kstep;
            const char* a2 = last ? nA : cA + (size_t)(t + 2) * kstep; const char* b2 = last ? nB : cB + (size_t)(t + 2) * kstep;
            const char* a3 = a2 + kstep; const char* b3 = b2 + kstep;
            if (last && has_next) S.a_ready(nxt);
            if constexpr (SP2) {
            PG8_LDB(B0, 0, 0); PG8_LDB(B1, 0, 1); PG8_SCHED; PG8_LDA(At, 0, 0); PG8_STAGE(PG8_SA(1, 1), a1 + hstep, voffA);
            PG8_WAIT_V(8); PG8_WAIT_L(0); PG8_BAR; PG8_MMA(0, 0, At, B0); PG8_MMA(0, 1, At, B1); PG8_BAR; PG8_SCHED;
            PG8_LDA(At, 0, 1); PG8_STAGE(PG8_SB(0, 0), b2, voffB); PG8_STAGE(PG8_SB(0, 1), b2 + hstep, voffB); PG8_STAGE(PG8_SA(0, 0), a2, voffA);
            PG8_WAIT_V(8); PG8_WAIT_L(0); PG8_BAR; PG8_MMA(1, 0, At, B0); PG8_MMA(1, 1, At, B1); PG8_BAR; PG8_SCHED;
            PG8_LDB(B0, 1, 0); PG8_LDB(B1, 1, 1); PG8_SCHED; PG8_LDA(At, 1, 0); PG8_STAGE(PG8_SA(0, 1), a2 + hstep, voffA);
            PG8_WAIT_V(8); PG8_WAIT_L(0); PG8_BAR; PG8_MMA(0, 0, At, B0); PG8_MMA(0, 1, At, B1); PG8_BAR; PG8_SCHED;
            PG8_LDA(At, 1, 1); PG8_STAGE(PG8_SB(1, 0), b3, voffB); PG8_STAGE(PG8_SB(1, 1), b3 + hstep, voffB); PG8_STAGE(PG8_SA(1, 0), a3, voffA);
            PG8_WAIT_V(8); PG8_WAIT_L(0); PG8_BAR; PG8_MMA(1, 0, At, B0); PG8_MMA(1, 1, At, B1); PG8_BAR; PG8_SCHED;
            } else {
            PG8_LDB(B0, 0, 0); PG8_SCHED; PG8_LDA(At, 0, 0); PG8_STAGE(PG8_SA(1, 1), a1 + hstep, voffA);
            PG8_WAIT_L(8); PG8_BAR; PG8_WAIT_L(0); PG8_MMA(0, 0, At, B0); PG8_BAR; PG8_SCHED;
            PG8_LDB(B1, 0, 1); PG8_STAGE(PG8_SB(0, 0), b2, voffB);
            PG8_BAR; PG8_WAIT_L(0); PG8_MMA(0, 1, At, B1); PG8_BAR;
            PG8_LDA(At, 0, 1); PG8_STAGE(PG8_SA(0, 0), a2, voffA);
            PG8_BAR; PG8_WAIT_L(0); PG8_MMA(1, 0, At, B0); PG8_BAR; PG8_SCHED;
            PG8_STAGE(PG8_SB(0, 1), b2 + hstep, voffB);
            PG8_WAIT_V(6); PG8_BAR; PG8_MMA(1, 1, At, B1); PG8_BAR;
            PG8_LDB(B0, 1, 0); PG8_SCHED; PG8_LDA(At, 1, 0); PG8_STAGE(PG8_SA(0, 1), a2 + hstep, voffA);
            PG8_WAIT_L(8); PG8_BAR; PG8_WAIT_L(0); PG8_MMA(0, 0, At, B0); PG8_BAR; PG8_SCHED;
            PG8_LDB(B1, 1, 1); PG8_STAGE(PG8_SB(1, 0), b3, voffB);
            PG8_BAR; PG8_WAIT_L(0); PG8_MMA(0, 1, At, B1); PG8_BAR;
            PG8_LDA(At, 1, 1); PG8_STAGE(PG8_SA(1, 0), a3, voffA);
            PG8_BAR; PG8_WAIT_L(0); PG8_MMA(1, 0, At, B0); PG8_BAR; PG8_SCHED;
            PG8_STAGE(PG8_SB(1, 1), b3 + hstep, voffB);
            PG8_WAIT_V(6); PG8_BAR; PG8_MMA(1, 1, At, B1); PG8_BAR;
            }
        }
        if constexpr (ALIGN_EPI) { if (wr == 0) PG8_BAR; }
        if constexpr (!Epi::AFTER_DRAIN) { E(acc, cur, wr, wc, fr, fq); S.done(cur); }
        if (!has_next) break;
#pragma unroll
        for (int a = 0; a < 2; ++a)
#pragma unroll
            for (int b = 0; b < 2; ++b)
#pragma unroll
                for (int m = 0; m < 4; ++m)
#pragma unroll
                    for (int n = 0; n < 2; ++n) acc[a][b][m][n] = (f32x4){0.f, 0.f, 0.f, 0.f};
        cur = nxt; cA = nA; cB = nB; ++ui; nt = S.nt_of(cur);
        if constexpr (ALIGN_EPI) { if (wr == 1) PG8_BAR; }
    }
    PG8_WAIT_V(0);
    if constexpr (!ALIGN_EPI) { if (wr == 0) PG8_BAR; }
    PG8_BAR;
    if constexpr (Epi::AFTER_DRAIN) { E.fused(acc, cur, wr, wc, fr, fq, lds, wid, lane); S.done(cur); }
#undef PG8_SA
#undef PG8_SB
#undef PG8_STAGE
#undef PG8_LDA
#undef PG8_LDB
#undef PG8_MMA
#undef PG8_WAIT_V
#undef PG8_WAIT_L
#undef PG8_BAR
#undef PG8_SCHED
}
}

#ifndef MK_N_LAUNCHES
#define MK_N_LAUNCHES 1
#endif
constexpr int NWAVES = 8;

constexpr int DM = 2048, NBATCH = 4, SEQ = 2048, NMETA = 16, DBATCH = 128, DSEQ = 8, PAST = 16384;
constexpr int NH = 8, DK = 256, DV = 512, RQK = 2048, RV = 4096, NRI = 2 * RQK + 2 * RV  , NCI = 4 * DM  ;
constexpr int ROW_S0 = NBATCH * SEQ  , ROW_M0 = ROW_S0 + DBATCH * DSEQ  , M_REAL = ROW_M0 + NMETA  , M_PAD = 9472  ;
constexpr int NPOS = NMETA + SEQ + DSEQ;
constexpr float LN_EPS = 1e-5f, GN_EPS = 1e-6f;
constexpr int LDP = 64, LD_X = DM + LDP  , LD_A2 = RV + LDP  , LD_PROJ = NRI + LDP  , LD_Y = RV + LDP  ;
constexpr float DN_ALPHA = 1.681792830507429f;
constexpr size_t O_YP = 0, O_YS = O_YP + (size_t)NBATCH * SEQ * DM, O_SRP = O_YS + (size_t)DBATCH * DSEQ * DM, O_SRS = O_SRP + (size_t)2 * NBATCH * NH * DK * DV,
                 O_SCP = O_SRS + (size_t)2 * DBATCH * NH * DK * DV, O_SCS = O_SCP + (size_t)2 * NBATCH * 2 * DM, O_END = O_SCS + (size_t)2 * DBATCH * 2 * DM;

constexpr size_t MiB = 1u << 20;
constexpr size_t WS_CTL = 0, CTL_ZERO_BYTES = 64 * 1024;
constexpr size_t WS_WRI = 2 * MiB;
constexpr size_t WS_WRO = WS_WRI + (size_t)2 * NRI * LD_X * 2;
constexpr size_t WS_WCI = WS_WRO + (size_t)2 * DM * LD_A2 * 2;
constexpr size_t WS_WCO = WS_WCI + (size_t)2 * NCI * LD_X * 2;
constexpr size_t WS_ROPE = WS_WCO + (size_t)2 * DM * LD_X * 2;
constexpr size_t WS_XF = WS_ROPE + 4 * MiB;
constexpr size_t WS_XB = WS_XF + (size_t)M_PAD * DM * 4;
constexpr size_t WS_PROJ = WS_XB + (size_t)M_PAD * LD_X * 2;
constexpr size_t WS_A2 = WS_PROJ + (size_t)M_PAD * LD_PROJ * 2;
constexpr size_t WS_H = WS_A2 + (size_t)M_PAD * LD_A2 * 2;
constexpr size_t WS_YF = WS_H + (size_t)M_PAD * DM * 4;
constexpr size_t WS_PART = WS_YF + (size_t)M_PAD * RV * 4;
constexpr int TAIL_KS = 4;
#ifndef MK_DEFER_CVT
#define MK_DEFER_CVT 1
#endif
constexpr int W_ALL = 0xFF, W_IN_PROLOGUE = MK_DEFER_CVT ? 0x03 : W_ALL;
constexpr size_t WS_END = WS_PART + (size_t)TAIL_KS * (M_PAD - ROW_S0) * DM * 4;
constexpr int CW_QUEUE = 1024;
constexpr int CW_BAR = 4096;

constexpr int RING_OFF = 0, RING_BYTES = 139264;
constexpr int LDSCTL_OFF = RING_BYTES, MISC_OFF = LDSCTL_OFF + 320;
constexpr int LDS_BYTES = 147456;

#define GAS __attribute__((address_space(1)))
#define LAS __attribute__((address_space(3)))
typedef unsigned short bf16;
typedef unsigned v4u __attribute__((ext_vector_type(4)));
typedef unsigned v2u __attribute__((ext_vector_type(2)));
typedef float f32x4 __attribute__((ext_vector_type(4)));
typedef GAS unsigned gu32;
#define RLX_AGENT __ATOMIC_RELAXED, __HIP_MEMORY_SCOPE_AGENT
#define LDS_WAIT() asm volatile("s_waitcnt lgkmcnt(0)" ::: "memory")
#define VM_WAIT() asm volatile("s_waitcnt vmcnt(0)" ::: "memory")
__device__ __forceinline__ unsigned f2bf(float f) { unsigned u = __builtin_bit_cast(unsigned, f); return (u + 0x7fffu + ((u >> 16) & 1u)) >> 16; }
__device__ __forceinline__ unsigned pk2(float lo, float hi) { return f2bf(lo) | (f2bf(hi) << 16); }
__device__ __forceinline__ float bf_lo(unsigned w) { return __builtin_bit_cast(float, w << 16); }
__device__ __forceinline__ float bf_hi(unsigned w) { return __builtin_bit_cast(float, w & 0xffff0000u); }
__device__ __forceinline__ float bf2f(bf16 b) { return __builtin_bit_cast(float, ((unsigned)b) << 16); }

#define XB_TMO      128
#define XB_XCNT(j)  (256  + 64 * (j))
#define XB_XSUB(j)  (1280 + 64 * (j))
#define XB_XGEN(j)  (2304 + 64 * (j))
#define XB_TOP      3328
#define XB_TOPGEN   3392
#define XCD_BAR_WORDS 3456
#define XB_SPIN_CAP (1u << 20)

__device__ __forceinline__ unsigned xb_ld(unsigned* p)              { return __hip_atomic_load(p, __ATOMIC_RELAXED, __HIP_MEMORY_SCOPE_AGENT); }
__device__ __forceinline__ unsigned xb_add(unsigned* p, unsigned v) { return __hip_atomic_fetch_add(p, v, __ATOMIC_RELAXED, __HIP_MEMORY_SCOPE_AGENT); }
__device__ __forceinline__ unsigned xb_xcc_id() { return (unsigned)__builtin_amdgcn_s_getreg((3 << 11) | 20) & 0xFu; }
#define XB_SPIN(cond, bar) do { unsigned _sp = 0; while (cond) { __builtin_amdgcn_s_sleep(1); \
    if ((++_sp & 255u) == 0u) { if (xb_ld(&(bar)[XB_TMO])) break; if (_sp > XB_SPIN_CAP) { atomicAdd(&(bar)[XB_TMO], 1u); break; } } } } while (0)

struct XcdBarrier { unsigned* bar; unsigned x; volatile LAS unsigned* st; };

__device__ __forceinline__ XcdBarrier xcd_barrier_post(unsigned* bar, volatile LAS unsigned* st) {
    XcdBarrier b; b.bar = bar; b.x = xb_xcc_id(); b.st = st;
    if (threadIdx.x == 0) (void)xb_add(&bar[XB_XCNT(b.x)], 1u);
    return b;
}
__device__ __forceinline__ void xcd_barrier_complete(unsigned* bar, unsigned x, unsigned& nloc, unsigned& nx) {
    const unsigned G = gridDim.x * gridDim.y * gridDim.z;
    unsigned sum, cnt, mine, sp = 0u;
    for (;;) {
        sum = 0u; cnt = 0u; mine = 0u;
#pragma unroll
        for (unsigned j = 0; j < 16; ++j) { const unsigned c = xb_ld(&bar[XB_XCNT(j)]); sum += c; cnt += (c > 0u) ? 1u : 0u; mine = (j == x) ? c : mine; }
        if (sum == G) break;
        __builtin_amdgcn_s_sleep(1);
        if ((++sp & 255u) == 0u) { if (xb_ld(&bar[XB_TMO])) break; if (sp > XB_SPIN_CAP) { atomicAdd(&bar[XB_TMO], 1u); break; } }
    }
    nloc = mine > 0u ? mine : 1u; nx = cnt > 0u ? cnt : 1u;
}
__device__ __forceinline__ void xcd_barrier(const XcdBarrier& b) {
    asm volatile("s_waitcnt vmcnt(0)" ::: "memory");
    __syncthreads();
    if (threadIdx.x == 0) {
        unsigned* bar = b.bar;
        __builtin_amdgcn_s_waitcnt(0);
        unsigned nloc = b.st[0], nx = b.st[1];
        if (nloc == 0u) { xcd_barrier_complete(bar, b.x, nloc, nx); b.st[0] = nloc; b.st[1] = nx; }
        const unsigned old = xb_add(&bar[XB_XSUB(b.x)], 1u);
        const unsigned gen = old / nloc;
        if (old + 1u == (gen + 1u) * nloc) {
            __builtin_amdgcn_fence(__ATOMIC_RELEASE, "agent");
            asm volatile("s_waitcnt vmcnt(0)" ::: "memory");
            const unsigned og = xb_add(&bar[XB_TOP], 1u);
            const unsigned tg = og / nx;
            if (og + 1u == (tg + 1u) * nx) xb_add(&bar[XB_TOPGEN], 1u);
            else XB_SPIN(xb_ld(&bar[XB_TOPGEN]) == tg, bar);
            __builtin_amdgcn_fence(__ATOMIC_ACQUIRE, "agent");
            xb_add(&bar[XB_XGEN(b.x)], 1u);
            asm volatile("s_waitcnt vmcnt(0)" ::: "memory");
        } else {
            XB_SPIN(xb_ld(&bar[XB_XGEN(b.x)]) == gen, bar);
            __builtin_amdgcn_fence(__ATOMIC_ACQUIRE, "agent");
            asm volatile("s_waitcnt vmcnt(0)" ::: "memory");
        }
    }
    __syncthreads();
}

struct Frame {
    LAS unsigned char* lds;
    volatile LAS unsigned* MISC;
    gu32* ctl;
    int tid, lane, wave, vcu, G;
    const float *x_prompt, *x_sample, *state_ret, *state_conv, *meta, *w_ret_in, *w_ret_out, *w_conv_in, *conv_w, *w_conv_out, *ln_g, *ln_b;
    float* out;
    bf16 *Wri, *Wro, *Wci, *Wco, *XB, *PROJ, *A2;
    float *YF, *ROPE, *PART; bf16 *YB, *HB, *QT;
};
__device__ __forceinline__ float wave_sum(float v) {
#pragma unroll
    for (int o = 1; o < 64; o <<= 1) v += __shfl_xor(v, o);
    return v;
}
__device__ __forceinline__ int row_pos_idx(int row) { return row < ROW_S0 ? (row & (SEQ - 1)) + NMETA : (row < ROW_M0 ? NMETA + SEQ + ((row - ROW_S0) & (DSEQ - 1)) : (row < M_REAL ? row - ROW_M0 : 0)); }

__host__ __device__ __forceinline__ int conv_col_perm(int n) { const int g = n >> 11, e = n & 2047, pn = e >> 6, el = e & 63; return 256 * pn + 128 * (g >> 1) + 32 * (el >> 4) + 8 * ((el >> 2) & 3) + 4 * (g & 1) + (el & 3); }
template <bool CPERM = false> __device__ __forceinline__ void p0_transpose_item(const float* W, int K, int N, bf16* WT, int ldw, LAS float* scr, int item, int lane) {
    const int nblk = N / 32, kb = item / nblk, nb = item % nblk, k0 = 64 * kb, n0 = 32 * nb;
#pragma unroll 8
    for (int i = 0; i < 32; ++i) { const int kk = 2 * i + (lane >> 5); scr[kk * 33 + (lane & 31)] = W[(size_t)(k0 + kk) * N + n0 + (lane & 31)]; }
    LDS_WAIT(); asm volatile("" ::: "memory");
    const int c = lane & 7;
#pragma unroll
    for (int j = 0; j < 4; ++j) { const int n = (lane >> 3) + 8 * j; const LAS float* s = scr + (8 * c) * 33 + n;
        v4u o; o.x = pk2(s[0 * 33], s[1 * 33]); o.y = pk2(s[2 * 33], s[3 * 33]); o.z = pk2(s[4 * 33], s[5 * 33]); o.w = pk2(s[6 * 33], s[7 * 33]);
        *(GAS v4u*)(WT + (size_t)(CPERM ? conv_col_perm(n0 + n) : n0 + n) * ldw + k0 + 8 * c) = o; }
    LDS_WAIT(); asm volatile("" ::: "memory");
}
__device__ __forceinline__ void sincos_d(float angf, float& s_out, float& c_out) {
    const double a = (double)angf;
    const double kq = rint(a * 0.63661977236758134308);
    double r = fma(-kq, 1.57079632679489655800e+00, a); r = fma(-kq, 6.12323399573676603587e-17, r);
    const double r2 = r * r;
    double sp = -7.6471637318198164759e-13; sp = fma(sp, r2, 1.6059043836821614599e-10); sp = fma(sp, r2, -2.5052108385441718775e-08); sp = fma(sp, r2, 2.7557319223985890653e-06);
    sp = fma(sp, r2, -1.9841269841269841270e-04); sp = fma(sp, r2, 8.3333333333333333333e-03); sp = fma(sp, r2, -1.6666666666666666667e-01); const double sn = fma(sp * r2, r, r);
    double cp = 4.7794773323873852974e-14; cp = fma(cp, r2, -1.1470745597729724714e-11); cp = fma(cp, r2, 2.0876756987868098979e-09); cp = fma(cp, r2, -2.7557319223985890653e-07);
    cp = fma(cp, r2, 2.4801587301587301587e-05); cp = fma(cp, r2, -1.3888888888888888889e-03); cp = fma(cp, r2, 4.1666666666666666667e-02); cp = fma(cp, r2, -0.5); const double cs = fma(cp, r2, 1.0);
    const int q = ((int)kq) & 3;
    const double S = (q == 0) ? sn : (q == 1) ? cs : (q == 2) ? -sn : -cs;
    const double C = (q == 0) ? cs : (q == 1) ? -sn : (q == 2) ? -cs : sn;
    s_out = (float)S; c_out = (float)C;
}

template <int MASK> __device__ __forceinline__ void convert_weights(Frame& F, int gw, int nw) {
    LAS float* scr = (LAS float*)(F.lds + RING_OFF + F.wave * 16384);
    constexpr int I_RI = (DM / 64) * (NRI / 32), I_RO = (RV / 64) * (DM / 32), I_CI = (DM / 64) * (NCI / 32), I_CO = (DM / 64) * (DM / 32);
    int lane = F.lane; asm volatile("" : "+v"(lane));
#pragma unroll
    for (int j = 0; j < 2; ++j) {
        if (MASK & (1 << (4 * j + 0))) for (int r = gw; r < I_RI; r += nw) p0_transpose_item(F.w_ret_in + (size_t)j * DM * NRI, DM, NRI, F.Wri + (size_t)j * NRI * LD_X, LD_X, scr, r, lane);
        if (MASK & (1 << (4 * j + 1))) for (int r = gw; r < I_RO; r += nw) p0_transpose_item(F.w_ret_out + (size_t)j * RV * DM, RV, DM, F.Wro + (size_t)j * DM * LD_A2, LD_A2, scr, r, lane);
        if (MASK & (1 << (4 * j + 2))) for (int r = gw; r < I_CI; r += nw) p0_transpose_item<true>(F.w_conv_in + (size_t)j * DM * NCI, DM, NCI, F.Wci + (size_t)j * NCI * LD_X, LD_X, scr, r, lane);
        if (MASK & (1 << (4 * j + 3))) for (int r = gw; r < I_CO; r += nw) p0_transpose_item(F.w_conv_out + (size_t)j * DM * DM, DM, DM, F.Wco + (size_t)j * DM * LD_X, LD_X, scr, r, lane);
    }
}
template <int MASK> __device__ __forceinline__ void convert_by_idle(Frame& F, int n_busy) {
    const int c = (int)blockIdx.x;
    if (MASK != 0 && c >= n_busy && F.G == 256) { F.lane = (int)__builtin_amdgcn_mbcnt_hi(~0u, __builtin_amdgcn_mbcnt_lo(~0u, 0u)); convert_weights<MASK>(F, (c - n_busy) * NWAVES + F.wave, (F.G - n_busy) * NWAVES); }
}
__device__ __forceinline__ void p0_prologue(Frame& F, const float* freq) {
    const int gw = F.vcu * NWAVES + F.wave, NGW = F.G * NWAVES;
    if (F.G == 256) convert_weights<W_IN_PROLOGUE>(F, gw, NGW); else convert_weights<W_ALL>(F, gw, NGW);
    for (int m = gw; m < M_PAD; m += NGW) {
        const float* src = m < ROW_S0 ? F.x_prompt + (size_t)m * DM : (m < ROW_M0 ? F.x_sample + (size_t)(m - ROW_S0) * DM : (m < M_REAL ? F.meta + (size_t)(m - ROW_M0) * DM : nullptr));
        v2u* xb = (v2u*)(F.XB + (size_t)m * LD_X) + F.lane;
#pragma unroll
        for (int j = 0; j < 8; ++j) { const f32x4 v = src ? ((const f32x4*)src)[F.lane + 64 * j] : (f32x4){0.f, 0.f, 0.f, 0.f}; v2u o; o.x = pk2(v.x, v.y); o.y = pk2(v.z, v.w); xb[64 * j] = o; }
    }
    const int gt = F.vcu * NWAVES * 64 + F.tid, NGT = F.G * NWAVES * 64;
    for (int i = gt; i < NPOS * 128; i += NGT) {
        const int p = i >> 7, d = i & 127; const int pos = p < NMETA + SEQ ? p : PAST + (p - (NMETA + SEQ));
        const float ang = (float)pos * freq[d]; float s, c; sincos_d(ang, s, c);
        F.ROPE[i] = c; F.ROPE[NPOS * 128 + i] = s;
    }
    if (gt < 128) { float s, c; sincos_d(16.0f * freq[gt], s, c); F.ROPE[2 * NPOS * 128 + gt] = c; F.ROPE[2 * NPOS * 128 + 128 + gt] = s; }
}

struct EpiResBf16 {
    static constexpr bool PERM = true, AFTER_DRAIN = false;
    bf16* C; const bf16* R; float* P; float alpha;
    __device__ __forceinline__ void operator()(const pg8::f32x4 (&acc)[2][2][4][2], const pg8::Unit& u, int wr, int wc, int fr, int fq) const {
        const int row0 = u.pm * pg8::BM + wr * 64 + fr, col0 = pg8::unit_pn(u) * pg8::BM + wc * 32 + 8 * fq, part = pg8::unit_part(u);
        if (part < 0) {
            v4u rr[2][4][2];
#pragma unroll
            for (int ai = 0; ai < 2; ++ai)
#pragma unroll
                for (int m = 0; m < 4; ++m)
#pragma unroll
                    for (int bj = 0; bj < 2; ++bj) rr[ai][m][bj] = *(const v4u*)(R + (size_t)(row0 + ai * pg8::HALF + m * 16) * LD_X + col0 + bj * pg8::HALF);
            asm volatile("" ::: "memory");
#pragma unroll
            for (int ai = 0; ai < 2; ++ai)
#pragma unroll
                for (int m = 0; m < 4; ++m) { const size_t off = (size_t)(row0 + ai * pg8::HALF + m * 16) * LD_X + col0;
#pragma unroll
                    for (int bj = 0; bj < 2; ++bj) { const v4u r = rr[ai][m][bj];
                        const pg8::f32x4 v0 = acc[ai][bj][m][0] + (pg8::f32x4){bf_lo(r.x), bf_hi(r.x), bf_lo(r.y), bf_hi(r.y)} * alpha, v1 = acc[ai][bj][m][1] + (pg8::f32x4){bf_lo(r.z), bf_hi(r.z), bf_lo(r.w), bf_hi(r.w)} * alpha;
                        pg8::u32x4 w; w.x = pg8::cvt_pk_bf16(v0[0], v0[1]); w.y = pg8::cvt_pk_bf16(v0[2], v0[3]); w.z = pg8::cvt_pk_bf16(v1[0], v1[1]); w.w = pg8::cvt_pk_bf16(v1[2], v1[3]);
                        *(pg8::u32x4*)(C + off + bj * pg8::HALF) = w; } }
        } else {
            bf16* Pp = (bf16*)P + (size_t)part * (M_PAD - ROW_S0) * DM;
#pragma unroll
            for (int ai = 0; ai < 2; ++ai)
#pragma unroll
                for (int m = 0; m < 4; ++m) { const size_t off = (size_t)(row0 - ROW_S0 + ai * pg8::HALF + m * 16) * DM + col0;
#pragma unroll
                    for (int bj = 0; bj < 2; ++bj) { const pg8::f32x4 v0 = acc[ai][bj][m][0], v1 = acc[ai][bj][m][1];
                        pg8::u32x4 w; w.x = pg8::cvt_pk_bf16(v0[0], v0[1]); w.y = pg8::cvt_pk_bf16(v0[2], v0[3]); w.z = pg8::cvt_pk_bf16(v1[0], v1[1]); w.w = pg8::cvt_pk_bf16(v1[2], v1[3]);
                        *(pg8::u32x4*)(Pp + off + bj * pg8::HALF) = w; } }
        }
    }
};

__device__ __forceinline__ f32x4 row_ror1(const f32x4 v) { f32x4 r;
#pragma unroll
    for (int j = 0; j < 4; ++j) { const float t = v[j]; r[j] = __int_as_float(__builtin_amdgcn_update_dpp(0, __float_as_int(t), 0x121, 0xf, 0xf, false)); }
    return r; }
__device__ __forceinline__ f32x4 row_ror2(const f32x4 v) { f32x4 r;
#pragma unroll
    for (int j = 0; j < 4; ++j) { const float t = v[j]; r[j] = __int_as_float(__builtin_amdgcn_update_dpp(0, __float_as_int(t), 0x122, 0xf, 0xf, false)); }
    return r; }
struct EpiConvGate {
    static constexpr bool PERM = true, AFTER_DRAIN = false;
    bf16* O; float* sp; float* ss;
    bf16* A; const float* cw; LAS float* xl;
    __device__ __forceinline__ void operator()(const pg8::f32x4 (&acc)[2][2][4][2], const pg8::Unit& u, int wr, int wc, int fr, int fq) const {
        const int row0 = u.pm * pg8::BM + wr * 64 + fr, e0 = 64 * u.pn + 16 * wc + 4 * fq;
        if (u.pm < ROW_S0 / pg8::BM) {
            const pg8::f32x4 w0 = *(const pg8::f32x4*)(cw + e0), w1 = *(const pg8::f32x4*)(cw + DM + e0), w2 = *(const pg8::f32x4*)(cw + 2 * DM + e0);
            pg8::f32x4 uu[2][4];
#pragma unroll
            for (int ai = 0; ai < 2; ++ai)
#pragma unroll
                for (int m = 0; m < 4; ++m) uu[ai][m] = acc[ai][0][m][1] * acc[ai][1][m][0];
            if (fr >= 14) {
#pragma unroll
                for (int ai = 0; ai < 2; ++ai) *(LAS pg8::f32x4*)(xl + (size_t)(((((wr * 4 + wc) * 2 + ai) * 2 + (fr - 14)) * 4 + fq) * 4)) = uu[ai][3];
            }
            { const int t = (row0 + pg8::HALF + 48) & (SEQ - 1);
              if (t >= SEQ - 2) *(pg8::f32x4*)(sp + ((size_t)((row0 + pg8::HALF + 48) >> 11) * 2 + (t - (SEQ - 2))) * DM + e0) = uu[1][3]; }
            LDS_WAIT(); __builtin_amdgcn_s_barrier(); asm volatile("" ::: "memory");
#pragma unroll
            for (int ai = 0; ai < 2; ++ai) {
                const int B = 2 * ai + wr;
                pg8::f32x4 P = {0.f, 0.f, 0.f, 0.f};
                if (B > 0 && fr >= 14) P = *(const LAS pg8::f32x4*)(xl + (size_t)((((((1 - wr) * 4 + wc) * 2 + (wr ? ai : ai - 1)) * 2 + (fr - 14)) * 4 + fq) * 4));
#pragma unroll
                for (int m = 0; m < 4; ++m) { const int row = row0 + ai * pg8::HALF + m * 16;
                    const pg8::f32x4 U = uu[ai][m], Pm = m == 0 ? P : uu[ai][m - 1];
                    const pg8::f32x4 a1 = row_ror1(U), b1 = row_ror1(Pm), a2 = row_ror2(U), b2 = row_ror2(Pm);
                    const pg8::f32x4 u1 = fr >= 1 ? a1 : b1, u2 = fr >= 2 ? a2 : b2;
                    const pg8::f32x4 b = acc[ai][0][m][0], z = acc[ai][1][m][1]; pg8::f32x4 g2, r;
#pragma unroll
                    for (int j = 0; j < 4; ++j) { g2[j] = z[j] * __builtin_amdgcn_rcpf(1.0f + __expf(-z[j])) * b[j]; r[j] = g2[j] * (w0[j] * u2[j] + w1[j] * u1[j] + w2[j] * U[j]); }
                    v2u w; w.x = pg8::cvt_pk_bf16(r[0], r[1]); w.y = pg8::cvt_pk_bf16(r[2], r[3]); *(v2u*)(A + (size_t)row * LD_X + e0) = w;
                    if ((B == 0 && m == 0 && fr < 2) || (B == 3 && m == 3 && fr >= 14)) { bf16* rp = O + (size_t)row * LD_PROJ + e0;
                        w.x = pg8::cvt_pk_bf16(U[0], U[1]); w.y = pg8::cvt_pk_bf16(U[2], U[3]); *(v2u*)rp = w;
                        w.x = pg8::cvt_pk_bf16(g2[0], g2[1]); w.y = pg8::cvt_pk_bf16(g2[2], g2[3]); *(v2u*)(rp + DM) = w; }
                }
            }
            return;
        }
#pragma unroll
        for (int ai = 0; ai < 2; ++ai)
#pragma unroll
            for (int m = 0; m < 4; ++m) { const int row = row0 + ai * pg8::HALF + m * 16;
                const pg8::f32x4 b = acc[ai][0][m][0], c = acc[ai][0][m][1], v = acc[ai][1][m][0], z = acc[ai][1][m][1];
                const pg8::f32x4 uu = c * v; pg8::f32x4 g2;
#pragma unroll
                for (int j = 0; j < 4; ++j) g2[j] = z[j] * __builtin_amdgcn_rcpf(1.0f + __expf(-z[j])) * b[j];
                bf16* rp = O + (size_t)row * LD_PROJ + e0;
                v2u w; w.x = pg8::cvt_pk_bf16(uu[0], uu[1]); w.y = pg8::cvt_pk_bf16(uu[2], uu[3]); *(v2u*)rp = w;
                w.x = pg8::cvt_pk_bf16(g2[0], g2[1]); w.y = pg8::cvt_pk_bf16(g2[2], g2[3]); *(v2u*)(rp + DM) = w;
                if (row >= ROW_S0 && row < ROW_M0) { const int s = (row - ROW_S0) & (DSEQ - 1); if (s >= DSEQ - 2) *(pg8::f32x4*)(ss + ((size_t)((row - ROW_S0) >> 3) * 2 + (s - (DSEQ - 2))) * DM + e0) = uu; }
            }
    }
};

struct EpiRopeBf16 {
    static constexpr bool PERM = true, AFTER_DRAIN = false;
    pg8::bf16_t* O; int ldc; const float* rope; pg8::bf16_t* QT;
    __device__ __forceinline__ void operator()(const pg8::f32x4 (&acc)[2][2][4][2], const pg8::Unit& u, int wr, int wc, int fr, int fq) const {
        const int row0 = u.pm * pg8::BM + wr * 64 + fr, col0 = u.pn * pg8::BM + wc * 32 + 8 * fq;
        if (u.pn < 16) {
            const bool isq = u.pn < 8; const int d0 = wc * 32 + 8 * fq;
            const float lgh = log2f(1.0f - exp2f(-5.0f - (float)(u.pn & 7)));
            const bool prow = u.pm < ROW_S0 / pg8::BM;
            pg8::f32x4 C0 = {1.f, 1.f, 1.f, 1.f}, C1 = C0, S0 = {0.f, 0.f, 0.f, 0.f}, S1 = S0;
            if (prow) { const float* stp = rope + (size_t)2 * NPOS * 128 + d0; C0 = *(const pg8::f32x4*)stp; C1 = *(const pg8::f32x4*)(stp + 4); S0 = *(const pg8::f32x4*)(stp + 128); S1 = *(const pg8::f32x4*)(stp + 132); }
            pg8::f32x4 cb0[2], cb1[2], sb0[2], sb1[2];
#pragma unroll
            for (int ai = 0; ai < 2; ++ai) { const float* ct = rope + (size_t)row_pos_idx(row0 + ai * pg8::HALF) * 128 + d0; const float* st = ct + (size_t)NPOS * 128;
                cb0[ai] = *(const pg8::f32x4*)ct; cb1[ai] = *(const pg8::f32x4*)(ct + 4); sb0[ai] = *(const pg8::f32x4*)st; sb1[ai] = *(const pg8::f32x4*)(st + 4); }
#pragma unroll
            for (int ai = 0; ai < 2; ++ai) {
                pg8::f32x4 rc0 = cb0[ai], rc1 = cb1[ai], rs0 = sb0[ai], rs1 = sb1[ai];
#pragma unroll
                for (int m = 0; m < 4; ++m) { const int row = row0 + ai * pg8::HALF + m * 16;
                    if (m > 0) { const pg8::f32x4 t0 = rc0 * C0 - rs0 * S0, t1 = rc1 * C1 - rs1 * S1; rs0 = rs0 * C0 + rc0 * S0; rs1 = rs1 * C1 + rc1 * S1; rc0 = t0; rc1 = t1; }
                    const int ci = row < ROW_S0 ? (row & 127) : (row >= ROW_M0 && row < M_REAL ? 112 + (row - ROW_M0) : 0);
                    const float sc = isq ? 0.0625f * __builtin_amdgcn_exp2f(lgh * (float)ci) : __builtin_amdgcn_exp2f(-lgh * (float)ci);
                    const pg8::f32x4 c0 = rc0 * sc, c1 = rc1 * sc, s0 = rs0 * sc, s1 = rs1 * sc;
                    const pg8::f32x4 a0 = acc[ai][0][m][0], a1 = acc[ai][0][m][1], b0 = acc[ai][1][m][0], b1 = acc[ai][1][m][1];
                    const pg8::f32x4 x0 = a0 * c0 - b0 * s0, x1 = a1 * c1 - b1 * s1, y0 = a0 * s0 + b0 * c0, y1 = a1 * s1 + b1 * c1;
                    const bool toqt = isq && (row < ROW_S0 || row >= ROW_M0);
                    const int ci2 = row < ROW_S0 ? (row & 127) : 112 + (row - ROW_M0);
                    const size_t blk = row < ROW_S0 ? (size_t)(((row >> 11) * NH + (u.pn & 7)) * 16 + ((row & 2047) >> 7)) * 4 + (ci2 >> 5) : (size_t)NBATCH * NH * 16 * 4 + (row < M_REAL ? 0 : NH) + (u.pn & 7);
                    pg8::bf16_t* qb = QT + blk * 8192 + ((size_t)((2 * wc + (fq >> 1)) * 64 + (fq & 1) * 32 + (ci2 & 31))) * 8;
                    pg8::bf16_t* pp = O + (size_t)row * ldc + col0;
                    pg8::bf16_t* p1 = toqt ? qb : pp; pg8::bf16_t* p2 = toqt ? qb + 8 * 64 * 8 : pp + pg8::HALF;
                    pg8::u32x4 w; w.x = pg8::cvt_pk_bf16(x0[0], x0[1]); w.y = pg8::cvt_pk_bf16(x0[2], x0[3]); w.z = pg8::cvt_pk_bf16(x1[0], x1[1]); w.w = pg8::cvt_pk_bf16(x1[2], x1[3]);
                    *(pg8::u32x4*)p1 = w;
                    w.x = pg8::cvt_pk_bf16(y0[0], y0[1]); w.y = pg8::cvt_pk_bf16(y0[2], y0[3]); w.z = pg8::cvt_pk_bf16(y1[0], y1[1]); w.w = pg8::cvt_pk_bf16(y1[2], y1[3]);
                    *(pg8::u32x4*)p2 = w; }
            }
        } else {
#pragma unroll
            for (int ai = 0; ai < 2; ++ai)
#pragma unroll
                for (int m = 0; m < 4; ++m) { pg8::bf16_t* rowp = O + (size_t)(row0 + ai * pg8::HALF + m * 16) * ldc + col0;
#pragma unroll
                    for (int bj = 0; bj < 2; ++bj) { const pg8::f32x4 v0 = acc[ai][bj][m][0], v1 = acc[ai][bj][m][1];
                        pg8::u32x4 w; w.x = pg8::cvt_pk_bf16(v0[0], v0[1]); w.y = pg8::cvt_pk_bf16(v0[2], v0[3]); w.z = pg8::cvt_pk_bf16(v1[0], v1[1]); w.w = pg8::cvt_pk_bf16(v1[2], v1[3]);
                        *(pg8::u32x4*)(rowp + bj * pg8::HALF) = w; } }
        }
    }
};

typedef float f32x2 __attribute__((ext_vector_type(2)));
struct SamplePre { v4u qk, v, g; };
__device__ __forceinline__ void sample_prefetch(Frame& F, int b, int h, SamplePre& p) {
    const int l = F.tid >> 6, c8 = F.tid & 63; const bf16* pr = F.PROJ + (size_t)(ROW_S0 + b * DSEQ + l) * LD_PROJ;
    p.qk = *(const v4u*)(pr + (c8 < 32 ? 0 : RQK) + h * DK + (c8 & 31) * 8);
    p.v = *(const v4u*)(pr + 2 * RQK + h * DV + c8 * 8);
    p.g = *(const v4u*)(pr + 2 * RQK + RV + h * DV + c8 * 8);
}
template <int VAR = 0, int PF = 8> __device__ __forceinline__ void retention_sample_unit(Frame& F, int lj, int b, int h, const SamplePre& pre) {
    LAS float* kq = (LAS float*)(F.lds + RING_OFF);
    LAS float* vl = (LAS float*)(F.lds + RING_OFF + 16384);
    LAS float* op = (LAS float*)(F.lds + RING_OFF + 32768);
    LAS float* Am = (LAS float*)(F.lds + RING_OFF + 98304);
    const float lg = log2f(1.0f - exp2f(-5.0f - (float)h));
    const int row0 = ROW_S0 + b * DSEQ;
    {
        const int l = F.tid >> 6, c8 = F.tid & 63; const bool isq = c8 < 32; const int d0 = (c8 & 31) * 8;
        const v4u w = pre.qk;
        const float sc = exp2f(lg * (isq ? (float)(l + 1) : (float)(7 - l)));
        const float e[8] = {bf_lo(w.x), bf_hi(w.x), bf_lo(w.y), bf_hi(w.y), bf_lo(w.z), bf_hi(w.z), bf_lo(w.w), bf_hi(w.w)};
#pragma unroll
        for (int j = 0; j < 8; ++j) kq[(d0 + j) * 16 + (isq ? 8 + l : l)] = e[j] * sc;
        const v4u wv = pre.v;
        LAS float* vd = vl + l * 512 + c8 * 8;
        vd[0] = bf_lo(wv.x); vd[1] = bf_hi(wv.x); vd[2] = bf_lo(wv.y); vd[3] = bf_hi(wv.y); vd[4] = bf_lo(wv.z); vd[5] = bf_hi(wv.z); vd[6] = bf_lo(wv.w); vd[7] = bf_hi(wv.w);
    }
    __syncthreads();
    {
        const int p = F.tid >> 3, part = F.tid & 7, l = p >> 3, m = p & 7; float a = 0.f;
        for (int d = part * 32; d < part * 32 + 32; ++d) a += kq[d * 16 + 8 + l] * kq[d * 16 + m];
        a += __shfl_xor(a, 1); a += __shfl_xor(a, 2); a += __shfl_xor(a, 4);
        if (part == 0) Am[p] = m <= l ? a * exp2f(-8.0f * lg) : 0.f;
    }
    const int rg = F.wave >> 1, vq = F.tid & 127;
    const float g8 = exp2f(8.0f * lg);
    f32x4 vv[8], o[8];
#pragma unroll
    for (int l = 0; l < 8; ++l) { vv[l] = *(const LAS f32x4*)(vl + l * 512 + 4 * vq); o[l] = (f32x4){0.f, 0.f, 0.f, 0.f}; }
    const size_t sbase = ((size_t)(lj * DBATCH + b) * NH + h) * DK * DV + (size_t)(rg * 64) * DV + 4 * vq;
    const f32x4* sp = (const f32x4*)(F.state_ret + sbase); f32x4* so = (f32x4*)(F.out + O_SRS + sbase);
    f32x4 buf[PF];
#pragma unroll
    for (int u = 0; u < PF; ++u) buf[u] = __builtin_nontemporal_load(sp + (size_t)u * (DV / 4));
    for (int i0 = 0; i0 < 64; i0 += PF) {
#pragma unroll
        for (int u = 0; u < PF; ++u) {
            const f32x4 s = buf[u];
            if (i0 + PF < 64) buf[u] = __builtin_nontemporal_load(sp + (size_t)(i0 + PF + u) * (DV / 4));
            if (VAR == 1) { o[0] += s; __builtin_nontemporal_store(s * g8, so + (size_t)(i0 + u) * (DV / 4)); continue; }
            if (VAR == 2) { o[0] += s; continue; }
            const LAS f32x4* kr = (const LAS f32x4*)(kq + (rg * 64 + i0 + u) * 16);
            const f32x4 k03 = kr[0], k47 = kr[1], q03 = kr[2], q47 = kr[3];
            o[0] += s * q03.x; o[1] += s * q03.y; o[2] += s * q03.z; o[3] += s * q03.w; o[4] += s * q47.x; o[5] += s * q47.y; o[6] += s * q47.z; o[7] += s * q47.w;
            f32x4 sn = s * g8;
            sn += vv[0] * k03.x; sn += vv[1] * k03.y; sn += vv[2] * k03.z; sn += vv[3] * k03.w; sn += vv[4] * k47.x; sn += vv[5] * k47.y; sn += vv[6] * k47.z; sn += vv[7] * k47.w;
            __builtin_nontemporal_store(sn, so + (size_t)(i0 + u) * (DV / 4));
        }
    }
#pragma unroll
    for (int l = 0; l < 8; ++l) *(LAS f32x4*)(op + (rg * 8 + l) * 512 + 4 * vq) = o[l];
    __syncthreads();
    {
        const int l = F.wave, v0 = 8 * F.lane; float y[8];
#pragma unroll
        for (int j = 0; j < 8; ++j) y[j] = 0.f;
#pragma unroll
        for (int r = 0; r < 4; ++r) { const f32x4 a = *(const LAS f32x4*)(op + (r * 8 + l) * 512 + v0), c = *(const LAS f32x4*)(op + (r * 8 + l) * 512 + v0 + 4);
            y[0] += a.x; y[1] += a.y; y[2] += a.z; y[3] += a.w; y[4] += c.x; y[5] += c.y; y[6] += c.z; y[7] += c.w; }
        for (int m = 0; m <= l; ++m) { const float am = Am[l * 8 + m]; const f32x4 a = *(const LAS f32x4*)(vl + m * 512 + v0), c = *(const LAS f32x4*)(vl + m * 512 + v0 + 4);
            y[0] += am * a.x; y[1] += am * a.y; y[2] += am * a.z; y[3] += am * a.w; y[4] += am * c.x; y[5] += am * c.y; y[6] += am * c.z; y[7] += am * c.w; }
        float s1 = 0.f;
#pragma unroll
        for (int j = 0; j < 8; ++j) s1 += y[j];
        const float mu = wave_sum(s1) * (1.f / DV); float s2 = 0.f;
#pragma unroll
        for (int j = 0; j < 8; ++j) { y[j] -= mu; s2 += y[j] * y[j]; }
        const float rs = 1.0f / sqrtf(wave_sum(s2) * (1.f / DV) + GN_EPS);
        const v4u gw4 = pre.g;
        const float g[8] = {bf_lo(gw4.x), bf_hi(gw4.x), bf_lo(gw4.y), bf_hi(gw4.y), bf_lo(gw4.z), bf_hi(gw4.z), bf_lo(gw4.w), bf_hi(gw4.w)};
        float r[8];
#pragma unroll
        for (int j = 0; j < 8; ++j) r[j] = g[j] / (1.0f + __expf(-g[j])) * (y[j] * rs);
        v4u w; w.x = pk2(r[0], r[1]); w.y = pk2(r[2], r[3]); w.z = pk2(r[4], r[5]); w.w = pk2(r[6], r[7]);
        *(v4u*)(F.A2 + (size_t)(row0 + l) * LD_A2 + h * DV + v0) = w;
    }
    __syncthreads();
}
typedef float f32x16 __attribute__((ext_vector_type(16)));
typedef short s16x8 __attribute__((ext_vector_type(8)));
typedef short s16x4 __attribute__((ext_vector_type(4)));
typedef short v4i16_t __attribute__((ext_vector_type(4)));
typedef __bf16 bf16x2_t __attribute__((ext_vector_type(2)));
__device__ __forceinline__ unsigned cvtpk(float lo, float hi) { const f32x2 v = {lo, hi}; return __builtin_bit_cast(unsigned, __builtin_convertvector(v, bf16x2_t)); }
__device__ __forceinline__ int crow(int r, int hk) { return (r & 3) + 8 * (r >> 2) + 4 * hk; }
__device__ __forceinline__ unsigned off_b(unsigned row, unsigned ch) { return 256u * row + 16u * (ch ^ (((row & 3u) << 2) | ((row >> 2) & 3u))); }
__device__ __forceinline__ unsigned offv(unsigned m, unsigned ch) { return 128u * m + 16u * (ch ^ (((m >> 1) & 1u) << 2)); }
__device__ __forceinline__ s16x4 tr_read(LAS unsigned char* p) { return __builtin_bit_cast(s16x4, __builtin_amdgcn_ds_read_tr16_b64_v4i16((LAS v4i16_t*)p)); }
__device__ __forceinline__ int tok_row(int c, int i, int b) { const int t = 128 * c + i - 112; return t < 0 ? -1 : (t < NMETA ? ROW_M0 + t : b * SEQ + (t - NMETA)); }
#define MFMA32(a, b, c) __builtin_amdgcn_mfma_f32_32x32x16_bf16((a), (b), (c), 0, 0, 0)
#define RP_LANES() int lane_ = (int)__builtin_amdgcn_mbcnt_hi(~0u, __builtin_amdgcn_mbcnt_lo(~0u, 0u)); asm volatile("" : "+v"(lane_)); const int lr = lane_ & 31, hk = lane_ >> 5, blk = (lane_ >> 4) & 1, q4 = (lane_ & 15) >> 2, p4 = lane_ & 3; const unsigned trsub = 8u * (p4 & 1); (void)lr; (void)hk; (void)blk; (void)q4; (void)trsub
#define RP_TID() int tid_ = (int)__builtin_amdgcn_mbcnt_hi(~0u, __builtin_amdgcn_mbcnt_lo(~0u, 0u)); asm volatile("" : "+v"(tid_)); tid_ += 64 * w
#define RP_SB() __builtin_amdgcn_sched_barrier(0)
__device__ __forceinline__ void rp_dma_kv(LAS unsigned char* KI, LAS unsigned char* VI, const bf16* Pk, const bf16* Pv, const void* zero16, int cc, int b, int w, int lane) {
#pragma unroll
    for (int i = 0; i < 8; ++i) { const int piece = w * 8 + i;
        const int dh = piece >> 5, r = 4 * (piece & 31) + (lane >> 4), pc = lane & 15, ch = pc ^ (((r & 3) << 2) | ((r >> 2) & 3));
        const int row = tok_row(cc, r, b);
        const void* g = row >= 0 ? (const void*)(Pk + (size_t)row * LD_PROJ + dh * 128 + 8 * ch) : zero16;
        __builtin_amdgcn_global_load_lds((const unsigned*)g, (LAS unsigned*)(KI + piece * 1024), 16, 0, 0); }
#pragma unroll
    for (int i = 0; i < 2; ++i) { const int piece = w * 2 + i;
        const int m = 8 * piece + (lane >> 3), pc = lane & 7, ch = pc ^ (((m >> 1) & 1) << 2);
        const int row = tok_row(cc, m, b);
        const void* g = row >= 0 ? (const void*)(Pv + (size_t)row * LD_PROJ + 8 * ch) : zero16;
        __builtin_amdgcn_global_load_lds((const unsigned*)g, (LAS unsigned*)(VI + piece * 1024), 16, 0, 0); }
}
template <int SKIP = 0> __device__ __forceinline__ void retention_prompt_mfma_unit(Frame& F, int lj, int uu) {
    LAS unsigned char* KI = F.lds + RING_OFF;
    LAS unsigned char* VI = F.lds + RING_OFF + 65536;
    LAS unsigned char* SI = F.lds + RING_OFF + 81920;
    LAS unsigned char* OT = F.lds + RING_OFF + 114688;
    const int vs = uu & 7, h = (uu >> 3) & 7, b = uu >> 6;
    const int w = F.wave;
    const int lb = w < 4 ? (w >> 1) : 3 - ((w - 4) >> 1), vb = w & 1;
    const float lg = log2f(1.0f - exp2f(-5.0f - (float)h));
    const bf16* Pk = F.PROJ + RQK + h * DK; const bf16* Pv = F.PROJ + 2 * RQK + h * DV + 64 * vs;
    { RP_TID(); for (int i = tid_; i < 32768 / 16; i += NWAVES * 64) *(LAS v4u*)(SI + 16 * i) = (v4u){0u, 0u, 0u, 0u}; }
    f32x16 Sacc[2];
#pragma unroll
    for (int r = 0; r < 16; ++r) { Sacc[0][r] = 0.f; Sacc[1][r] = 0.f; }
    s16x8 Qf[16], Qn[8];
    const void* zero16 = (const void*)((const unsigned char*)F.ctl + 8192);
    { RP_TID(); RP_LANES(); (void)tid_;
      rp_dma_kv(KI, VI, Pk, Pv, zero16, 0, b, w, lane_);
      { const bf16* q0 = F.QT + ((size_t)NBATCH * NH * 16 * 4 + h) * 8192 + lane_ * 8; const bool qv = lb == 3 && lr >= 16;
#pragma unroll
        for (int s = 0; s < 16; ++s) Qf[s] = qv ? *(const s16x8*)(q0 + s * 512) : (s16x8){0, 0, 0, 0, 0, 0, 0, 0}; }
    }
    asm volatile("s_waitcnt vmcnt(0)" ::: "memory");
    __syncthreads();
    for (int c = 0; c < 17; ++c) {
        if (c < 16 && !(SKIP & 8)) { RP_LANES();
          { const bf16* qn = F.QT + ((size_t)(((b * NH + h) * 16 + c) * 4 + lb)) * 8192 + lane_ * 8;
#pragma unroll
            for (int s = 0; s < 8; ++s) Qn[s] = *(const s16x8*)(qn + s * 512); }
        }
        RP_SB();
#define RP_F_BLOCK() { RP_LANES(); \
            LAS unsigned char* kbase = KI + (w >> 2) * 32768 + trsub; const unsigned chk = 4 * (w & 3) + 2 * blk + (p4 >> 1); \
            LAS unsigned char* vbase = VI + trsub; const unsigned chv = 2 * blk + (p4 >> 1); \
            _Pragma("unroll") for (int s = 0; s < ((SKIP & 4) ? 0 : 8); ++s) { \
                const unsigned mrow = 16 * s + 8 * hk + q4; \
                const s16x4 k0 = tr_read(kbase + off_b(mrow, chk)), k1 = tr_read(kbase + off_b(mrow + 4, chk)); \
                const s16x8 Ka = __builtin_shufflevector(k0, k1, 0, 1, 2, 3, 4, 5, 6, 7); \
                _Pragma("unroll") for (int v2 = 0; v2 < 2; ++v2) { \
                    const s16x4 v0 = tr_read(vbase + offv(mrow, 4 * v2 + chv)), v1 = tr_read(vbase + offv(mrow + 4, 4 * v2 + chv)); \
                    const s16x8 Vb = __builtin_shufflevector(v0, v1, 0, 1, 2, 3, 4, 5, 6, 7); \
                    Sacc[v2] = MFMA32(Ka, Vb, Sacc[v2]); } } }
        if (w >= 4) RP_F_BLOCK();
        RP_SB();
        f32x16 Oacc;
#pragma unroll
        for (int r = 0; r < 16; ++r) Oacc[r] = 0.f;
        for (int mb = 0; mb <= ((SKIP & 1) ? -1 : lb); ++mb) { RP_LANES();
            f32x16 Sc;
#pragma unroll
            for (int r = 0; r < 16; ++r) Sc[r] = 0.f;
            LAS unsigned char* krow = KI + 256 * (32 * mb + lr); const unsigned xr = ((lr & 3) << 2) | ((lr >> 2) & 3);
#pragma unroll
            for (int s = 0; s < 16; ++s) { const s16x8 a = *(const LAS s16x8*)(krow + (s >> 3) * 32768 + 16 * ((2 * (s & 7) + hk) ^ xr)); Sc = MFMA32(a, Qf[s], Sc); }
            if (mb == lb) {
#pragma unroll
                for (int r = 0; r < 16; ++r) Sc[r] = lr >= crow(r, hk) ? Sc[r] : 0.f;
            }
#pragma unroll
            for (int s2 = 0; s2 < 2; ++s2) {
                v4u pw; pw.x = cvtpk(Sc[8 * s2 + 0], Sc[8 * s2 + 1]); pw.y = cvtpk(Sc[8 * s2 + 2], Sc[8 * s2 + 3]); pw.z = cvtpk(Sc[8 * s2 + 4], Sc[8 * s2 + 5]); pw.w = cvtpk(Sc[8 * s2 + 6], Sc[8 * s2 + 7]);
                const s16x8 Pf = __builtin_bit_cast(s16x8, pw);
                const unsigned m0 = 32 * mb + 16 * s2 + 4 * hk + q4, chv = 4 * vb + 2 * blk + (p4 >> 1);
                const s16x4 lo = tr_read(VI + offv(m0, chv) + trsub), hi = tr_read(VI + offv(m0 + 8, chv) + trsub);
                const s16x8 Va = __builtin_shufflevector(lo, hi, 0, 1, 2, 3, 4, 5, 6, 7);
                Oacc = MFMA32(Va, Pf, Oacc);
            }
        }
        RP_SB();
        if (w < 4) RP_F_BLOCK();
        RP_SB();
#undef RP_F_BLOCK
        __syncthreads();
        if (c < 16 && !(SKIP & 16)) { RP_LANES(); rp_dma_kv(KI, VI, Pk, Pv, zero16, c + 1, b, w, lane_); }
        { RP_LANES();
            LAS unsigned char* srow = SI + 256 * (32 * vb + lr); const unsigned xr = ((lr & 3) << 2) | ((lr >> 2) & 3);
            if (!(SKIP & 2)) {
#pragma unroll
            for (int s = 0; s < 16; ++s) { const s16x8 a = *(const LAS s16x8*)(srow + (s >> 3) * 16384 + 16 * ((2 * (s & 7) + hk) ^ xr)); Oacc = MFMA32(a, Qf[s], Oacc); }
            }
          { LAS unsigned char* op = OT + 144 * (32 * lb + lr) + 2 * (32 * vb + 4 * hk);
#pragma unroll
            for (int g4 = 0; g4 < 4; ++g4) { v2u o; o.x = cvtpk(Oacc[4 * g4], Oacc[4 * g4 + 1]); o.y = cvtpk(Oacc[4 * g4 + 2], Oacc[4 * g4 + 3]); *(LAS v2u*)(op + 16 * g4) = o; } }
          if (c < 16 && !(SKIP & 8)) { const bf16* qn = F.QT + ((size_t)(((b * NH + h) * 16 + c) * 4 + lb)) * 8192 + lane_ * 8;
#pragma unroll
            for (int s = 8; s < 16; ++s) Qf[s] = *(const s16x8*)(qn + s * 512); }
        }
        RP_SB();
        asm volatile("s_waitcnt lgkmcnt(0)" ::: "memory"); __builtin_amdgcn_s_barrier(); asm volatile("" ::: "memory");
        { RP_TID();
#pragma unroll
          for (int i = 0; i < 2; ++i) { const int idx = tid_ + 512 * i, r = idx >> 3, ch = idx & 7; const int row = tok_row(c, r, b);
              if (row >= 0 && (c > 0 || b == 0)) *(v4u*)(F.YB + (size_t)row * LD_Y + h * DV + 64 * vs + 8 * ch) = *(const LAS v4u*)(OT + 144 * r + 16 * ch); } }
        { RP_LANES(); RP_TID();
          const float g128 = __builtin_amdgcn_exp2f(128.0f * lg);
#pragma unroll
          for (int r = 0; r < 16; ++r) { Sacc[0][r] *= g128; Sacc[1][r] *= g128; }
#pragma unroll
          for (int v2 = 0; v2 < 2; ++v2)
#pragma unroll
            for (int g4 = 0; g4 < 4; ++g4) { v2u o; o.x = cvtpk(Sacc[v2][4 * g4], Sacc[v2][4 * g4 + 1]); o.y = cvtpk(Sacc[v2][4 * g4 + 2], Sacc[v2][4 * g4 + 3]);
                *(LAS v2u*)(SI + (w >> 2) * 16384 + off_b(32 * v2 + lr, 4 * (w & 3) + g4) + 8 * hk) = o; }
          if (c < 16) {
#pragma unroll
            for (int s = 0; s < 8; ++s) Qf[s] = Qn[s];
          }
        }
        asm volatile("s_waitcnt vmcnt(0)" ::: "memory");
        __syncthreads();
    }
    { RP_LANES(); const float ginv = __builtin_amdgcn_exp2f(-lg);
      float* so = F.out + O_SRP + ((size_t)(lj * NBATCH + b) * NH + h) * DK * DV + 64 * vs + lr;
#pragma unroll
      for (int v2 = 0; v2 < 2; ++v2)
#pragma unroll
          for (int r = 0; r < 16; ++r) so[(size_t)(32 * w + crow(r, hk)) * DV + 32 * v2] = Sacc[v2][r] * ginv; }
    __syncthreads();
}
__device__ __forceinline__ void retention_phase(Frame& F, int lj, int what = 3) {
    const int half = F.G >> 1, me = F.vcu >> 1;
    if (what == 3 && F.G >= 2) {
        if (!(F.vcu & 1)) { for (int u = me; u < NBATCH * NH * 8; u += half) retention_prompt_mfma_unit(F, lj, u); }
        gu32* qhead = F.ctl + CW_QUEUE + 64 * lj;
        F.lane = (int)__builtin_amdgcn_mbcnt_hi(~0u, __builtin_amdgcn_mbcnt_lo(~0u, 0u)); asm volatile("" : "+v"(F.lane)); F.tid = F.wave * 64 + F.lane;
        SamplePre p0, p1;
        __syncthreads();
        if (F.tid == 0) F.MISC[16] = __hip_atomic_fetch_add(qhead, 1u, RLX_AGENT);
        __syncthreads();
        int u0 = (int)F.MISC[16];
        if (u0 < DBATCH * NH) sample_prefetch(F, u0 >> 3, u0 & 7, p0);
        while (u0 < DBATCH * NH) {
            __syncthreads();
            if (F.tid == 0) F.MISC[16] = __hip_atomic_fetch_add(qhead, 1u, RLX_AGENT);
            __syncthreads();
            const int u1 = (int)F.MISC[16];
            if (u1 < DBATCH * NH) sample_prefetch(F, u1 >> 3, u1 & 7, p1);
            retention_sample_unit(F, lj, u0 >> 3, u0 & 7, p0);
            u0 = u1; p0 = p1;
        }
        return;
    }
    if (what == 70) { if (!(F.vcu & 1)) for (int u = me; u < NBATCH * NH * 8; u += half) retention_prompt_mfma_unit(F, lj, u); return; }
    if (what == 71) { if (F.vcu & 1) for (int u = me; u < DBATCH * NH; u += half) { SamplePre pp; sample_prefetch(F, u >> 3, u & 7, pp); retention_sample_unit(F, lj, u >> 3, u & 7, pp); } return; }
    if (what >= 64) { for (int u = F.vcu; u < NBATCH * NH * 8; u += F.G) { if (what == 64) retention_prompt_mfma_unit<1>(F, lj, u); else if (what == 65) retention_prompt_mfma_unit<2>(F, lj, u); else if (what == 66) retention_prompt_mfma_unit<4>(F, lj, u); else if (what == 67) retention_prompt_mfma_unit<8>(F, lj, u); else if (what == 68) retention_prompt_mfma_unit<24>(F, lj, u); else retention_prompt_mfma_unit<0>(F, lj, u); } return; }
    if (what == 8) { for (int u = F.vcu; u < DBATCH * NH; u += F.G) { SamplePre pp; sample_prefetch(F, u >> 3, u & 7, pp); retention_sample_unit<1>(F, lj, u >> 3, u & 7, pp); } return; }
    if (what == 32) { if ((F.vcu & 3) == 3) for (int u = F.vcu >> 2; u < DBATCH * NH; u += F.G >> 2) { SamplePre pp; sample_prefetch(F, u >> 3, u & 7, pp); retention_sample_unit<1, 16>(F, lj, u >> 3, u & 7, pp); } return; }
    if (what == 16) { for (int u = F.vcu; u < DBATCH * NH; u += F.G) { SamplePre pp; sample_prefetch(F, u >> 3, u & 7, pp); retention_sample_unit<2>(F, lj, u >> 3, u & 7, pp); } return; }
    if (what & 1) for (int u = F.vcu; u < NBATCH * NH * 8; u += F.G) retention_prompt_mfma_unit(F, lj, u);
    F.lane = (int)__builtin_amdgcn_mbcnt_hi(~0u, __builtin_amdgcn_mbcnt_lo(~0u, 0u)); asm volatile("" : "+v"(F.lane)); F.tid = F.wave * 64 + F.lane;
    if (what & 2) for (int u = F.vcu; u < DBATCH * NH; u += F.G) { SamplePre pp; sample_prefetch(F, u >> 3, u & 7, pp); retention_sample_unit(F, lj, u >> 3, u & 7, pp); }
}

__device__ __forceinline__ void groupnorm_gate_phase(Frame& F) {
    const int gw = F.vcu * NWAVES + F.wave, NGW = F.G * NWAVES;
    for (int it = gw; it < M_PAD * NH; it += NGW) {
        const int row = it >> 3, h = it & 7;
        v4u* o = (v4u*)(F.A2 + (size_t)row * LD_A2 + h * DV) + F.lane;
        if (row >= ROW_S0 && row < ROW_M0) continue;
        if (row >= M_REAL) { *o = (v4u){0u, 0u, 0u, 0u}; continue; }
        const v4u yw = *((const v4u*)(F.YB + (size_t)row * LD_Y + h * DV) + F.lane);
        const f32x4 y0 = {bf_lo(yw.x), bf_hi(yw.x), bf_lo(yw.y), bf_hi(yw.y)}, y1 = {bf_lo(yw.z), bf_hi(yw.z), bf_lo(yw.w), bf_hi(yw.w)};
        const float mu = wave_sum((y0.x + y0.y) + (y0.z + y0.w) + (y1.x + y1.y) + (y1.z + y1.w)) * (1.f / DV);
        const f32x4 d0 = y0 - mu, d1 = y1 - mu;
        const float var = wave_sum((d0.x * d0.x + d0.y * d0.y) + (d0.z * d0.z + d0.w * d0.w) + (d1.x * d1.x + d1.y * d1.y) + (d1.z * d1.z + d1.w * d1.w)) * (1.f / DV);
        const float rs = 1.0f / sqrtf(var + GN_EPS);
        const v4u gw4 = *((const v4u*)(F.PROJ + (size_t)row * LD_PROJ + 2 * RQK + RV + h * DV) + F.lane);
        float g[8] = {bf_lo(gw4.x), bf_hi(gw4.x), bf_lo(gw4.y), bf_hi(gw4.y), bf_lo(gw4.z), bf_hi(gw4.z), bf_lo(gw4.w), bf_hi(gw4.w)};
        float yn[8] = {d0.x * rs, d0.y * rs, d0.z * rs, d0.w * rs, d1.x * rs, d1.y * rs, d1.z * rs, d1.w * rs};
        float r[8];
#pragma unroll
        for (int j = 0; j < 8; ++j) r[j] = g[j] / (1.0f + __expf(-g[j])) * yn[j];
        v4u w; w.x = pk2(r[0], r[1]); w.y = pk2(r[2], r[3]); w.z = pk2(r[4], r[5]); w.w = pk2(r[6], r[7]);
        *o = w;
    }
}

__device__ __forceinline__ void layernorm_phase(Frame& F, int layer, bool last) {
    const int gw = F.vcu * NWAVES + F.wave, NGW = F.G * NWAVES;
    for (int row = gw; row < M_PAD; row += NGW) {
        float v[4][8]; float s = 0.f;
        if (row < ROW_S0) {
            const v4u* hp = (const v4u*)(F.HB + (size_t)row * LD_X) + F.lane;
#pragma unroll
            for (int j = 0; j < 4; ++j) { const v4u w = hp[64 * j]; v[j][0] = bf_lo(w.x); v[j][1] = bf_hi(w.x); v[j][2] = bf_lo(w.y); v[j][3] = bf_hi(w.y); v[j][4] = bf_lo(w.z); v[j][5] = bf_hi(w.z); v[j][6] = bf_lo(w.w); v[j][7] = bf_hi(w.w); }
        } else {
            const v4u* xp = (const v4u*)(F.XB + (size_t)row * LD_X) + F.lane; const v4u* pp = (const v4u*)((const bf16*)F.PART + (size_t)(row - ROW_S0) * DM) + F.lane;
#pragma unroll
            for (int j = 0; j < 4; ++j) { const v4u w = xp[64 * j];
                f32x4 a0 = (f32x4){bf_lo(w.x), bf_hi(w.x), bf_lo(w.y), bf_hi(w.y)} * DN_ALPHA, a1 = (f32x4){bf_lo(w.z), bf_hi(w.z), bf_lo(w.w), bf_hi(w.w)} * DN_ALPHA;
#pragma unroll
                for (int k = 0; k < TAIL_KS; ++k) { const v4u q = pp[(size_t)k * (M_PAD - ROW_S0) * (DM / 8) + 64 * j];
                    a0 += (f32x4){bf_lo(q.x), bf_hi(q.x), bf_lo(q.y), bf_hi(q.y)}; a1 += (f32x4){bf_lo(q.z), bf_hi(q.z), bf_lo(q.w), bf_hi(q.w)}; }
                v[j][0] = a0.x; v[j][1] = a0.y; v[j][2] = a0.z; v[j][3] = a0.w; v[j][4] = a1.x; v[j][5] = a1.y; v[j][6] = a1.z; v[j][7] = a1.w; }
        }
#pragma unroll
        for (int j = 0; j < 4; ++j)
#pragma unroll
            for (int e = 0; e < 8; ++e) s += v[j][e];
        const float mean = wave_sum(s) * (1.f / DM); float s2 = 0.f;
#pragma unroll
        for (int j = 0; j < 4; ++j)
#pragma unroll
            for (int e = 0; e < 8; ++e) { v[j][e] -= mean; s2 += v[j][e] * v[j][e]; }
        const float rstd = 1.f / sqrtf(wave_sum(s2) * (1.f / DM) + LN_EPS);
        const f32x4* gp = (const f32x4*)(F.ln_g + (size_t)layer * DM) + 2 * F.lane; const f32x4* bp = (const f32x4*)(F.ln_b + (size_t)layer * DM) + 2 * F.lane;
        v4u* xb = (v4u*)(F.XB + (size_t)row * LD_X) + F.lane;
        f32x4* od = nullptr;
        if (last) { if (row < ROW_S0) od = (f32x4*)(F.out + O_YP + (size_t)row * DM) + 2 * F.lane; else if (row < ROW_M0) od = (f32x4*)(F.out + O_YS + (size_t)(row - ROW_S0) * DM) + 2 * F.lane; }
#pragma unroll
        for (int j = 0; j < 4; ++j) { const f32x4 g0 = gp[128 * j], g1 = gp[128 * j + 1], b0 = bp[128 * j], b1 = bp[128 * j + 1];
            const f32x4 y0 = (f32x4){v[j][0], v[j][1], v[j][2], v[j][3]} * rstd * g0 + b0, y1 = (f32x4){v[j][4], v[j][5], v[j][6], v[j][7]} * rstd * g1 + b1;
            if (last) { if (od) { od[128 * j] = y0; od[128 * j + 1] = y1; } }
            else { v4u o; o.x = pk2(y0.x, y0.y); o.y = pk2(y0.z, y0.w); o.z = pk2(y1.x, y1.y); o.w = pk2(y1.z, y1.w); xb[64 * j] = o; } }
    }
}

__device__ __forceinline__ void conv_phase(Frame& F, int lj) {
    const int gt = F.vcu * NWAVES * 64 + F.tid, NGT = F.G * NWAVES * 64;
    const float* cw = F.conv_w + (size_t)lj * 3 * DM;
    for (int it = gt; it < (2 * (ROW_S0 / 256) + M_PAD - ROW_S0) * (DM / 8); it += NGT) {
        const int ri = it >> 8, e0 = (it & 255) * 8; const int row = ri < 2 * (ROW_S0 / 256) ? (ri >> 1) * 256 + (ri & 1) : ROW_S0 + (ri - 2 * (ROW_S0 / 256));
        v4u* o = (v4u*)(F.A2 + (size_t)row * LD_X + e0);
        if (row >= M_REAL) { *o = (v4u){0u, 0u, 0u, 0u}; continue; }
        int r1, r2;
        if (row < ROW_S0) { const int t = row & (SEQ - 1); r1 = t >= 1 ? row - 1 : ROW_M0 + 15; r2 = t >= 2 ? row - 2 : (t == 1 ? ROW_M0 + 15 : ROW_M0 + 14); }
        else if (row < ROW_M0) { const int s = (row - ROW_S0) & (DSEQ - 1); r1 = s >= 1 ? row - 1 : -3; r2 = s >= 2 ? row - 2 : (s == 1 ? -3 : -2); }
        else { const int j = row - ROW_M0; r1 = j >= 1 ? row - 1 : -1; r2 = j >= 2 ? row - 2 : -1; }
        float u0[8], u1[8], u2[8];
        const bf16* pr = F.PROJ + (size_t)row * LD_PROJ + e0;
        { const v4u w = *(const v4u*)pr; u0[0] = bf_lo(w.x); u0[1] = bf_hi(w.x); u0[2] = bf_lo(w.y); u0[3] = bf_hi(w.y); u0[4] = bf_lo(w.z); u0[5] = bf_hi(w.z); u0[6] = bf_lo(w.w); u0[7] = bf_hi(w.w); }
#pragma unroll
        for (int k = 1; k <= 2; ++k) {
            const int rr = k == 1 ? r1 : r2; float* uu = k == 1 ? u1 : u2;
            if (rr >= 0) { const v4u w = *(const v4u*)(F.PROJ + (size_t)rr * LD_PROJ + e0);
                uu[0] = bf_lo(w.x); uu[1] = bf_hi(w.x); uu[2] = bf_lo(w.y); uu[3] = bf_hi(w.y); uu[4] = bf_lo(w.z); uu[5] = bf_hi(w.z); uu[6] = bf_lo(w.w); uu[7] = bf_hi(w.w); }
            else if (rr == -1) {
#pragma unroll
                for (int j = 0; j < 8; ++j) uu[j] = 0.f; }
            else { const int srow = -2 - rr; const int sb = (row - ROW_S0) >> 3; const float* sp = F.state_conv + (((size_t)lj * DBATCH + sb) * 2 + srow) * DM + e0;
                const f32x4 a = *(const f32x4*)sp, bq = *(const f32x4*)(sp + 4); uu[0] = a.x; uu[1] = a.y; uu[2] = a.z; uu[3] = a.w; uu[4] = bq.x; uu[5] = bq.y; uu[6] = bq.z; uu[7] = bq.w; }
        }
        const v4u gg = *(const v4u*)(pr + DM);
        const float gf[8] = {bf_lo(gg.x), bf_hi(gg.x), bf_lo(gg.y), bf_hi(gg.y), bf_lo(gg.z), bf_hi(gg.z), bf_lo(gg.w), bf_hi(gg.w)};
        float r[8];
#pragma unroll
        for (int j = 0; j < 8; ++j) r[j] = gf[j] * (cw[e0 + j] * u2[j] + cw[DM + e0 + j] * u1[j] + cw[2 * DM + e0 + j] * u0[j]);
        v4u w; w.x = pk2(r[0], r[1]); w.y = pk2(r[2], r[3]); w.z = pk2(r[4], r[5]); w.w = pk2(r[6], r[7]); *o = w;
    }
}

#define IN(k) (lo <= (k) && (k) < hi)
#define OPAQUE(p) asm volatile("" : "+s"(p))
#define FRESH() do { F.lane = (int)__builtin_amdgcn_mbcnt_hi(~0u, __builtin_amdgcn_mbcnt_lo(~0u, 0u)); asm volatile("" : "+v"(F.lane)); F.tid = F.wave * 64 + F.lane; asm volatile("" : "+s"(F.vcu)); } while (0)
#define SEAM(k) do { if (IN((k) + 1)) xcd_barrier(bar); } while (0)
#define SEAM2(k) do { if (IN((k) + 2)) xcd_barrier(bar); } while (0)

#ifndef GEMM_ALIGN
#define GEMM_ALIGN true
#endif
#ifndef GEMM_SP2
#define GEMM_SP2 true
#endif
#ifndef MK_PROBE
#define MK_PROBE 0
#endif
#define PROBE_REP(mask, call) do { if ((MK_PROBE) & (mask)) { xcd_barrier(bar); call; } } while (0)
template <int lj> __device__ __forceinline__ void gemm_ret_in(Frame& F) {
    const bf16* gA = F.XB; const bf16* gB = F.Wri + (size_t)lj * NRI * LD_X; OPAQUE(gA); OPAQUE(gB); pg8::Gemm g{gA, gB, M_PAD, NRI, DM, LD_X}; pg8::StaticOrder S; S.init(M_PAD, NRI, DM, F.G, (int)blockIdx.x);
    EpiRopeBf16 E{F.PROJ, LD_PROJ, F.ROPE, F.QT};
    pg8::gemm_phase<EpiRopeBf16, pg8::StaticOrder, GEMM_ALIGN, GEMM_SP2>(F.lds + RING_OFF, g, S, E, F.wave);
}
template <int lj> __device__ __forceinline__ void gemm_ret_out(Frame& F) {
    const bf16* gA = F.A2; const bf16* gB = F.Wro + (size_t)lj * DM * LD_A2; OPAQUE(gA); OPAQUE(gB); pg8::Gemm g{gA, gB, M_PAD, DM, RV, LD_A2}; pg8::TailOrder S; S.init(ROW_S0, M_PAD, DM, g.K, TAIL_KS, F.G, (int)blockIdx.x);
    EpiResBf16 E{F.HB, F.XB, F.PART, DN_ALPHA};
    pg8::gemm_phase<EpiResBf16, pg8::TailOrder, GEMM_ALIGN, GEMM_SP2>(F.lds + RING_OFF, g, S, E, F.wave);
}
template <int lj> __device__ __forceinline__ void gemm_conv_in(Frame& F) {
    const bf16* gA = F.XB; const bf16* gB = F.Wci + (size_t)lj * NCI * LD_X; OPAQUE(gA); OPAQUE(gB); pg8::Gemm g{gA, gB, M_PAD, NCI, DM, LD_X}; pg8::StaticOrder S; S.init(M_PAD, NCI, DM, F.G, (int)blockIdx.x);
    EpiConvGate E{F.PROJ, F.out + O_SCP + (size_t)lj * NBATCH * 2 * DM, F.out + O_SCS + (size_t)lj * DBATCH * 2 * DM, F.A2, F.conv_w + (size_t)lj * 3 * DM, (LAS float*)(F.lds + RING_OFF + 131072)};
    pg8::gemm_phase<EpiConvGate, pg8::StaticOrder, GEMM_ALIGN, GEMM_SP2>(F.lds + RING_OFF, g, S, E, F.wave);
}
template <int lj> __device__ __forceinline__ void gemm_conv_out(Frame& F) {
    const bf16* gA = F.A2; const bf16* gB = F.Wco + (size_t)lj * DM * LD_X; OPAQUE(gA); OPAQUE(gB); pg8::Gemm g{gA, gB, M_PAD, DM, DM, LD_X}; pg8::TailOrder S; S.init(ROW_S0, M_PAD, DM, g.K, TAIL_KS, F.G, (int)blockIdx.x);
    EpiResBf16 E{F.HB, F.XB, F.PART, DN_ALPHA};
    pg8::gemm_phase<EpiResBf16, pg8::TailOrder, GEMM_ALIGN, GEMM_SP2>(F.lds + RING_OFF, g, S, E, F.wave);
}
struct EpiNull { static constexpr bool PERM = true, AFTER_DRAIN = false; float* sink;
    __device__ __forceinline__ void operator()(const pg8::f32x4 (&acc)[2][2][4][2], const pg8::Unit& u, int wr, int wc, int fr, int fq) const { pg8::f32x4 t = {0.f, 0.f, 0.f, 0.f};
#pragma unroll
        for (int a = 0; a < 2; ++a)
#pragma unroll
            for (int b = 0; b < 2; ++b)
#pragma unroll
                for (int m = 0; m < 4; ++m) { t += acc[a][b][m][0]; t += acc[a][b][m][1]; }
        if (t[0] + t[1] + t[2] + t[3] == 123456.789f) sink[0] = 1.f; } };
template <int lj, int which> __device__ __forceinline__ void gemm_null(Frame& F) {
    const bf16* gA = (which == 0 || which == 2) ? F.XB : F.A2;
    const bf16* gB = which == 0 ? F.Wri + (size_t)lj * NRI * LD_X : which == 1 ? F.Wro + (size_t)lj * DM * LD_A2 : which == 2 ? F.Wci + (size_t)lj * NCI * LD_X : F.Wco + (size_t)lj * DM * LD_X;
    OPAQUE(gA); OPAQUE(gB);
    constexpr int N = which == 0 ? NRI : which == 2 ? NCI : DM, K = which == 1 ? RV : DM, LD = which == 1 ? LD_A2 : LD_X;
    pg8::Gemm g{gA, gB, M_PAD, N, K, LD}; EpiNull E{F.PART};
    if (which == 0 || which == 2) { pg8::StaticOrder S; S.init(M_PAD, N, K, F.G, (int)blockIdx.x); pg8::gemm_phase<EpiNull, pg8::StaticOrder, GEMM_ALIGN, GEMM_SP2>(F.lds + RING_OFF, g, S, E, F.wave); }
    else { pg8::TailOrder S; S.init(ROW_S0, M_PAD, N, K, TAIL_KS, F.G, (int)blockIdx.x); pg8::gemm_phase<EpiNull, pg8::TailOrder, GEMM_ALIGN, GEMM_SP2>(F.lds + RING_OFF, g, S, E, F.wave); }
}
constexpr int N_TAIL_UNITS = (M_PAD - ROW_S0) / 256 * (DM / 256) * TAIL_KS;
template <int lj> __device__ __forceinline__ void layer_pair(Frame& F, const XcdBarrier& bar, const int lo, const int hi) {
    const int pb = 1 + 10 * lj;
    if (IN(pb + 0)) { if ((MK_PROBE) & 512) { gemm_null<lj, 0>(F); xcd_barrier(bar); } gemm_ret_in<lj>(F); PROBE_REP(2, gemm_ret_in<lj>(F)); SEAM(pb + 0); }
    if (IN(pb + 2)) { if ((MK_PROBE) & 64) { FRESH(); retention_phase(F, lj, 8); xcd_barrier(bar); } if ((MK_PROBE) & 128) { FRESH(); retention_phase(F, lj, 16); xcd_barrier(bar); } if ((MK_PROBE) & 256) { FRESH(); retention_phase(F, lj, 32); xcd_barrier(bar); } if ((MK_PROBE) >= 1024) { FRESH(); retention_phase(F, lj, 64 + ((MK_PROBE) >> 10) - 1); xcd_barrier(bar); } FRESH(); retention_phase(F, lj); PROBE_REP(4, FRESH(); retention_phase(F, lj)); PROBE_REP(16, FRESH(); retention_phase(F, lj, 1)); PROBE_REP(32, FRESH(); retention_phase(F, lj, 2)); SEAM(pb + 2); }
    if (IN(pb + 3)) { FRESH(); groupnorm_gate_phase(F); PROBE_REP(8, FRESH(); groupnorm_gate_phase(F)); SEAM(pb + 3); }
    if (IN(pb + 4)) { if ((MK_PROBE) & 512) { gemm_null<lj, 1>(F); xcd_barrier(bar); } gemm_ret_out<lj>(F); if (MK_DEFER_CVT) convert_by_idle<(0x4 << (4 * lj))>(F, N_TAIL_UNITS); PROBE_REP(2, gemm_ret_out<lj>(F)); SEAM(pb + 4); }
    if (IN(pb + 5)) { FRESH(); layernorm_phase(F, 2 * lj, false); SEAM(pb + 5); }
    if (IN(pb + 6)) { if ((MK_PROBE) & 512) { gemm_null<lj, 2>(F); xcd_barrier(bar); } gemm_conv_in<lj>(F); if (MK_DEFER_CVT) convert_by_idle<(lj == 0 ? 0x18 : 0x80)>(F, (M_PAD / 256) * (NCI / 256) % 256); PROBE_REP(2, gemm_conv_in<lj>(F)); SEAM(pb + 6); }
    if (IN(pb + 7)) { FRESH(); conv_phase(F, lj); PROBE_REP(8, FRESH(); conv_phase(F, lj)); SEAM(pb + 7); }
    if (IN(pb + 8)) { if ((MK_PROBE) & 512) { gemm_null<lj, 3>(F); xcd_barrier(bar); } gemm_conv_out<lj>(F); if (MK_DEFER_CVT) convert_by_idle<(lj == 0 ? 0x20 : 0)>(F, N_TAIL_UNITS); PROBE_REP(2, gemm_conv_out<lj>(F)); SEAM(pb + 8); }
    if (IN(pb + 9)) { FRESH(); layernorm_phase(F, 2 * lj + 1, lj == 1); SEAM(pb + 9); }
}

constexpr int NPHASE = 21;
struct Args { const float* in[12]; float* out; unsigned char* ws; float freq[128]; int ph_lo, ph_hi; };
__global__ void __launch_bounds__(NWAVES * 64, 2) mk_fwd(Args args) {
    extern __shared__ __attribute__((aligned(16))) unsigned char lds[];
    Frame F;
    F.lds = (LAS unsigned char*)lds;
    F.MISC = (volatile LAS unsigned*)(F.lds + MISC_OFF);
    F.tid = threadIdx.x; F.lane = F.tid & 63; F.wave = __builtin_amdgcn_readfirstlane(F.tid >> 6);
    F.G = gridDim.x; { const int bx = blockIdx.x; F.vcu = (F.G % 8 == 0) ? (bx % 8) * (F.G / 8) + bx / 8 : bx; }
    unsigned char* ws = args.ws;
    F.ctl = (gu32*)(ws + WS_CTL);
    F.x_prompt = args.in[0]; F.x_sample = args.in[1]; F.state_ret = args.in[2]; F.state_conv = args.in[3]; F.meta = args.in[4]; F.w_ret_in = args.in[5];
    F.w_ret_out = args.in[6]; F.w_conv_in = args.in[7]; F.conv_w = args.in[8]; F.w_conv_out = args.in[9]; F.ln_g = args.in[10]; F.ln_b = args.in[11];
    F.out = args.out;
    F.Wri = (bf16*)(ws + WS_WRI); F.Wro = (bf16*)(ws + WS_WRO); F.Wci = (bf16*)(ws + WS_WCI); F.Wco = (bf16*)(ws + WS_WCO);
    F.XB = (bf16*)(ws + WS_XB); F.PROJ = (bf16*)(ws + WS_PROJ); F.A2 = (bf16*)(ws + WS_A2);
    F.HB = (bf16*)(ws + WS_H); F.QT = (bf16*)(ws + WS_XF); F.PART = (float*)(ws + WS_PART); F.YF = (float*)(ws + WS_YF); F.YB = (bf16*)(ws + WS_YF); F.ROPE = (float*)(ws + WS_ROPE);
    for (int u = F.tid; u < (LDS_BYTES - LDSCTL_OFF) / 4; u += NWAVES * 64) ((LAS unsigned*)(F.lds + LDSCTL_OFF))[u] = 0u;
    __syncthreads();
    XcdBarrier bar; bar.bar = (unsigned*)(F.ctl + CW_BAR); bar.x = 0; bar.st = nullptr;
    if (MK_N_LAUNCHES == 1) bar = xcd_barrier_post((unsigned*)(F.ctl + CW_BAR), F.MISC + 8);
    const int lo = args.ph_lo, hi = args.ph_hi;
    if (IN(0)) { FRESH(); p0_prologue(F, args.freq); PROBE_REP(1, FRESH(); p0_prologue(F, args.freq)); SEAM(0); }
    layer_pair<0>(F, bar, lo, hi);
    layer_pair<1>(F, bar, lo, hi);
#undef IN
#undef SEAM
}

extern "C" void kernel_launch(void* const* d_in, const int* in_sizes, int n_in, void* d_out, int out_size, void* d_ws, size_t ws_size, hipStream_t stream) {
    static int grid = 0;
    if (grid == 0) {
        if (n_in != 12 || (size_t)out_size != O_END || ws_size < WS_END) { fprintf(stderr, "kernel_launch: unexpected shapes: n_in %d out %d ws %zu (need %zu)\n", n_in, out_size, ws_size, (size_t)WS_END); grid = -1; return; }
        int dev = 0, cus = 0, per_cu = 0;
        if (hipGetDevice(&dev) != hipSuccess || hipDeviceGetAttribute(&cus, hipDeviceAttributeMultiprocessorCount, dev) != hipSuccess) { grid = -1; return; }
        if (hipFuncSetAttribute((const void*)mk_fwd, hipFuncAttributeMaxDynamicSharedMemorySize, LDS_BYTES) != hipSuccess) { fprintf(stderr, "kernel_launch: hipFuncSetAttribute failed\n"); grid = -1; return; }
        if (hipOccupancyMaxActiveBlocksPerMultiprocessor(&per_cu, (const void*)mk_fwd, NWAVES * 64, LDS_BYTES) != hipSuccess || per_cu < 1) { fprintf(stderr, "kernel_launch: occupancy query says %d blocks per CU\n", per_cu); }
        (void)hipGetLastError();
        grid = cus;
    }
    if (grid < 0) return;
    if (hipMemsetAsync((char*)d_ws + WS_CTL, 0, CTL_ZERO_BYTES, stream) != hipSuccess) { fprintf(stderr, "kernel_launch: memset failed\n"); return; }
    Args a{};
    for (int i = 0; i < 12; ++i) a.in[i] = (const float*)d_in[i];
    a.out = (float*)d_out; a.ws = (unsigned char*)d_ws;
    for (int d = 0; d < 128; ++d) a.freq[d] = (float)pow(10000.0, -(double)d / 128.0);
#if MK_N_LAUNCHES == 1
    a.ph_lo = 0; a.ph_hi = NPHASE;
    hipLaunchKernelGGL(mk_fwd, dim3(grid), dim3(NWAVES * 64), LDS_BYTES, stream, a);
#else
    for (int p = 0; p < NPHASE; ++p) { a.ph_lo = p; a.ph_hi = p + 1; hipLaunchKernelGGL(mk_fwd, dim3(grid), dim3(NWAVES * 64), LDS_BYTES, stream, a); }
#endif
    const hipError_t le = hipPeekAtLastError();
    if (le != hipSuccess) fprintf(stderr, "kernel_launch: launch failed: %s\n", hipGetErrorName(le));
}
```
